# Optimizing an MI355X kernel written in HIP

```python
import jax, jax.numpy as jnp
from jax import lax
import numpy as np

D_MODEL = 1024
BATCH = 32
SEQ = 2048
DEPTH = 1

D_MIX = D_MODEL
CONV_CH = 512
CONV_WIDTH = 3
N_HEADS = 8
HEAD_DIM = 64
N_KV_HEADS = 2
Q_PER_KV = N_HEADS // N_KV_HEADS
KV_DIM = N_KV_HEADS * HEAD_DIM
N_BRANCH = 3
CMP_LEN = 32
CMP_STRIDE = 16
SEL_BLOCK = 64
SEL_TOPK = 8
WINDOW = 512
NSA_Q_BLOCK = 64
FORCED_SCORE = 1e4
N_EXPERTS = 256
TOP_K = 8
N_GROUPS = 8
TOPK_GROUPS = 4
EXPERT_HIDDEN = 256
SHARED_HIDDEN = 256
ROUTED_SCALE = 2.5
DISPATCH_BLOCK = 128
LN_EPS = 1e-5
ALPHA = (2.0 * DEPTH) ** 0.25
BETA = (8.0 * DEPTH) ** -0.25
NEG_INF = -1e30
SPLIT_WIDTHS = (CONV_CH, CONV_CH, CONV_CH, N_HEADS * HEAD_DIM,
                KV_DIM, KV_DIM, KV_DIM, KV_DIM, KV_DIM, KV_DIM, N_HEADS * N_BRANCH)
D_IN_PROJ = 3 * CONV_CH + N_HEADS * HEAD_DIM + 6 * KV_DIM + N_HEADS * N_BRANCH

kernel_name = "hybrid_conv_nsa_moe_deepnorm"


def layer_norm(x, g, b):
    xf = x.astype(jnp.float32)
    mu = xf.mean(-1, keepdims=True)
    var = jnp.square(xf - mu).mean(-1, keepdims=True)
    return ((xf - mu) * lax.rsqrt(var + LN_EPS) * g.astype(jnp.float32)
            + b.astype(jnp.float32)).astype(x.dtype)


def masked_softmax(s, mask):
    s = jnp.where(mask, s.astype(jnp.float32), NEG_INF)
    return jax.nn.softmax(s, axis=-1) * mask


def alibi_slopes():
    return 2.0 ** (-8.0 * jnp.arange(1, N_HEADS + 1, dtype=jnp.float32) / N_HEADS)


def swiglu(x, wg, wu, wd):
    return (jax.nn.silu(x @ wg) * (x @ wu)) @ wd


def short_conv_mixer(b_gate, c_gate, u_in, conv_w):
    u = c_gate * u_in
    S = u.shape[1]
    up = jnp.pad(u, ((0, 0), (CONV_WIDTH - 1, 0), (0, 0)))
    y = sum(conv_w[j] * up[:, j:j + S] for j in range(CONV_WIDTH))
    return b_gate * y


def compress_blocks(blk, pos, w1, b1, w2):
    B, n = blk.shape[:2]
    blk = blk + pos[None, None, :, None, :]
    blk = blk.transpose(0, 1, 3, 2, 4).reshape(B, n, N_KV_HEADS, CMP_LEN * HEAD_DIM)
    return jax.nn.gelu(blk @ w1 + b1) @ w2


def native_sparse_attention(q, kc_raw, vc_raw, ks, vs, kw, vw, gate_logits,
                            ck_pos, ck_w1, ck_b1, ck_w2, cv_pos, cv_w1, cv_b1, cv_w2):
    B, S = q.shape[:2]
    G, R, Dh, Q = N_KV_HEADS, Q_PER_KV, HEAD_DIM, NSA_Q_BLOCK
    n_cmp = (S - CMP_LEN) // CMP_STRIDE + 1
    n_sel = S // SEL_BLOCK
    top_n = min(SEL_TOPK, n_sel)
    slopes = alibi_slopes().reshape(G, R)
    qg = q.reshape(B, S, G, R, Dh) * (HEAD_DIM ** -0.5)
    gates = jax.nn.sigmoid(gate_logits.astype(jnp.float32)).astype(q.dtype).reshape(B, S, G, R, N_BRANCH)
    kc_raw, vc_raw, ks, vs, kw, vw = [a.reshape(B, S, G, Dh) for a in (kc_raw, vc_raw, ks, vs, kw, vw)]

    cmp_start = jnp.arange(n_cmp) * CMP_STRIDE
    cmp_end = cmp_start + CMP_LEN - 1
    blk_idx = cmp_start[:, None] + jnp.arange(CMP_LEN)[None, :]
    kc = compress_blocks(kc_raw[:, blk_idx], ck_pos, ck_w1, ck_b1, ck_w2)
    vc = compress_blocks(vc_raw[:, blk_idx], cv_pos, cv_w1, cv_b1, cv_w2)

    sel_start = jnp.arange(n_sel) * SEL_BLOCK
    overlap = ((cmp_start[:, None] < sel_start[None, :] + SEL_BLOCK)
               & (cmp_end[:, None] >= sel_start[None, :])).astype(jnp.float32)

    ks_blocks = ks.reshape(B, n_sel, SEL_BLOCK, G, Dh).transpose(0, 3, 1, 2, 4)
    vs_blocks = vs.reshape(B, n_sel, SEL_BLOCK, G, Dh).transpose(0, 3, 1, 2, 4)
    kw_pad = jnp.pad(kw, ((0, 0), (WINDOW, 0), (0, 0), (0, 0)))
    vw_pad = jnp.pad(vw, ((0, 0), (WINDOW, 0), (0, 0), (0, 0)))
    b_ix = jnp.arange(B)[:, None, None, None]
    g_ix = jnp.arange(G)[None, :, None, None]
    blk_ids = jnp.arange(n_sel)

    def query_block(qi):
        q0 = qi * Q
        t = q0 + jnp.arange(Q)
        qb = lax.dynamic_slice_in_dim(qg, q0, Q, axis=1)
        gb = lax.dynamic_slice_in_dim(gates, q0, Q, axis=1)

        d_c = t[:, None] - cmp_end[None, :]
        s_c = jnp.einsum('bqgrd,bngd->bgrqn', qb, kc).astype(jnp.float32)
        s_c = s_c - slopes[:, :, None, None] * d_c.astype(jnp.float32)
        p_cmp = masked_softmax(s_c, d_c >= 0)
        o_cmp = jnp.einsum('bgrqn,bngd->bqgrd', p_cmp.astype(vc.dtype), vc)

        imp = jnp.einsum('bgrqn,nj->bgqj', p_cmp, overlap)
        forced = (blk_ids[None, :] == 0) | (blk_ids[None, :] == (t // SEL_BLOCK)[:, None])
        causal_blk = sel_start[None, :] <= t[:, None]
        score = jnp.where(forced, FORCED_SCORE, jnp.where(causal_blk, imp, -1.0))
        _, sel = lax.top_k(score, top_n)
        k_g = ks_blocks[b_ix, g_ix, sel]
        v_g = vs_blocks[b_ix, g_ix, sel].reshape(B, G, Q, top_n * SEL_BLOCK, Dh)
        pos = sel[..., None] * SEL_BLOCK + jnp.arange(SEL_BLOCK)
        d_s = (t[None, None, :, None, None] - pos)[:, :, None]
        s_s = jnp.einsum('bqgrd,bgqnld->bgrqnl', qb, k_g).astype(jnp.float32)
        s_s = s_s - slopes[None, :, :, None, None, None] * d_s.astype(jnp.float32)
        p_s = masked_softmax(s_s.reshape(B, G, R, Q, top_n * SEL_BLOCK),
                             (d_s >= 0).reshape(B, G, 1, Q, top_n * SEL_BLOCK))
        o_slc = jnp.einsum('bgrqm,bgqmd->bqgrd', p_s.astype(v_g.dtype), v_g)

        kwb = lax.dynamic_slice_in_dim(kw_pad, q0, WINDOW + Q, axis=1)
        vwb = lax.dynamic_slice_in_dim(vw_pad, q0, WINDOW + Q, axis=1)
        pos_w = q0 - WINDOW + jnp.arange(WINDOW + Q)
        d_w = t[:, None] - pos_w[None, :]
        m_w = (d_w >= 0) & (d_w < WINDOW) & (pos_w[None, :] >= 0)
        s_w = jnp.einsum('bqgrd,bkgd->bgrqk', qb, kwb).astype(jnp.float32)
        s_w = s_w - slopes[:, :, None, None] * d_w.astype(jnp.float32)
        p_w = masked_softmax(s_w, m_w)
        o_win = jnp.einsum('bgrqk,bkgd->bqgrd', p_w.astype(vwb.dtype), vwb)

        o = gb[..., 0:1] * o_cmp + gb[..., 1:2] * o_slc + gb[..., 2:3] * o_win
        return o.reshape(B, Q, N_HEADS * Dh).astype(q.dtype)

    out = lax.map(query_block, jnp.arange(S // Q))
    return out.transpose(1, 0, 2, 3).reshape(B, S, N_HEADS * Dh)


def moe_ffn(x, router_w, router_bias, w_gate, w_up, w_down, ws_gate, ws_up, ws_down):
    B, S, D = x.shape
    T = B * S
    xf = x.reshape(T, D)
    shared = swiglu(xf, ws_gate, ws_up, ws_down)

    scores = jax.nn.sigmoid((xf @ router_w).astype(jnp.float32))
    biased = scores + router_bias.astype(jnp.float32)
    grp = biased.reshape(T, N_GROUPS, N_EXPERTS // N_GROUPS)
    grp_score = lax.top_k(grp, 2)[0].sum(-1)
    _, top_grp = lax.top_k(grp_score, TOPK_GROUPS)
    grp_mask = jax.nn.one_hot(top_grp, N_GROUPS).sum(-2) > 0
    expert_mask = jnp.repeat(grp_mask, N_EXPERTS // N_GROUPS, axis=-1)
    _, top_e = lax.top_k(jnp.where(expert_mask, biased, NEG_INF), TOP_K)
    w = jnp.take_along_axis(scores, top_e, axis=-1)
    w = w / w.sum(-1, keepdims=True) * ROUTED_SCALE

    A = T * TOP_K
    flat_e = top_e.reshape(A)
    flat_tok = jnp.repeat(jnp.arange(T, dtype=jnp.int32), TOP_K)
    flat_w = w.reshape(A).astype(x.dtype)
    order = jnp.argsort(flat_e)
    e_s, tok_s, w_s = flat_e[order], flat_tok[order], flat_w[order]
    counts = jnp.bincount(flat_e, length=N_EXPERTS)
    padded = (counts + DISPATCH_BLOCK - 1) // DISPATCH_BLOCK * DISPATCH_BLOCK
    start = jnp.cumsum(counts) - counts
    pad_end = jnp.cumsum(padded)
    pad_start = pad_end - padded
    dest = pad_start[e_s] + jnp.arange(A) - start[e_s]
    n_blocks = -(-(A + N_EXPERTS * (DISPATCH_BLOCK - 1)) // DISPATCH_BLOCK)
    P = n_blocks * DISPATCH_BLOCK
    tok_pad = jnp.zeros((P,), jnp.int32).at[dest].set(tok_s)
    w_pad = jnp.zeros((P,), x.dtype).at[dest].set(w_s)
    blk_e = jnp.minimum(jnp.searchsorted(pad_end, jnp.arange(n_blocks) * DISPATCH_BLOCK,
                                         side='right'), N_EXPERTS - 1)

    def expert_block(y, inp):
        tok, wt, e = inp
        xb = xf[tok]
        out = swiglu(xb, w_gate[e], w_up[e], w_down[e]) * wt[:, None]
        return y.at[tok].add(out.astype(y.dtype)), None

    routed, _ = lax.scan(expert_block, jnp.zeros_like(xf),
                         (tok_pad.reshape(n_blocks, DISPATCH_BLOCK),
                          w_pad.reshape(n_blocks, DISPATCH_BLOCK), blk_e))
    return (shared + routed).reshape(B, S, D)


def setup_inputs(seed: int = 0) -> dict:
    key = jax.random.key(seed)
    ks = jax.random.split(key, 24)
    f32 = jnp.float32
    L = DEPTH

    def nrm(k, shape, scale):
        return jax.random.normal(k, shape, f32) * scale

    return {
        "x": nrm(ks[0], (BATCH, SEQ, D_MODEL), 1.0),
        "w_in": nrm(ks[1], (L, D_MODEL, D_IN_PROJ), D_MODEL ** -0.5),
        "conv_w": nrm(ks[2], (L, CONV_WIDTH, CONV_CH), CONV_WIDTH ** -0.5),
        "ck_pos": nrm(ks[3], (L, CMP_LEN, HEAD_DIM), 0.1),
        "ck_w1": nrm(ks[4], (L, CMP_LEN * HEAD_DIM, HEAD_DIM), (CMP_LEN * HEAD_DIM) ** -0.5),
        "ck_b1": nrm(ks[5], (L, HEAD_DIM), 0.02),
        "ck_w2": nrm(ks[6], (L, HEAD_DIM, HEAD_DIM), HEAD_DIM ** -0.5),
        "cv_pos": nrm(ks[7], (L, CMP_LEN, HEAD_DIM), 0.1),
        "cv_w1": nrm(ks[8], (L, CMP_LEN * HEAD_DIM, HEAD_DIM), (CMP_LEN * HEAD_DIM) ** -0.5),
        "cv_b1": nrm(ks[9], (L, HEAD_DIM), 0.02),
        "cv_w2": nrm(ks[10], (L, HEAD_DIM, HEAD_DIM), HEAD_DIM ** -0.5),
        "w_out": nrm(ks[11], (L, D_MIX, D_MODEL), D_MIX ** -0.5 * BETA),
        "ln1_g": 1.0 + nrm(ks[12], (L, D_MODEL), 0.02),
        "ln1_b": nrm(ks[13], (L, D_MODEL), 0.02),
        "router_w": nrm(ks[14], (L, D_MODEL, N_EXPERTS), D_MODEL ** -0.5),
        "router_bias": nrm(ks[15], (L, N_EXPERTS), 0.01),
        "w_gate": nrm(ks[16], (L, N_EXPERTS, D_MODEL, EXPERT_HIDDEN), D_MODEL ** -0.5),
        "w_up": nrm(ks[17], (L, N_EXPERTS, D_MODEL, EXPERT_HIDDEN), D_MODEL ** -0.5),
        "w_down": nrm(ks[18], (L, N_EXPERTS, EXPERT_HIDDEN, D_MODEL), EXPERT_HIDDEN ** -0.5 * BETA),
        "ws_gate": nrm(ks[19], (L, D_MODEL, SHARED_HIDDEN), D_MODEL ** -0.5),
        "ws_up": nrm(ks[20], (L, D_MODEL, SHARED_HIDDEN), D_MODEL ** -0.5),
        "ws_down": nrm(ks[21], (L, SHARED_HIDDEN, D_MODEL), SHARED_HIDDEN ** -0.5 * BETA),
        "ln2_g": 1.0 + nrm(ks[22], (L, D_MODEL), 0.02),
        "ln2_b": nrm(ks[23], (L, D_MODEL), 0.02),
    }


def reference(x, w_in, conv_w, ck_pos, ck_w1, ck_b1, ck_w2, cv_pos, cv_w1, cv_b1, cv_w2,
              w_out, ln1_g, ln1_b, router_w, router_bias, w_gate, w_up, w_down,
              ws_gate, ws_up, ws_down, ln2_g, ln2_b):
    offsets = []
    acc = 0
    for w in SPLIT_WIDTHS[:-1]:
        acc += w
        offsets.append(acc)
    for l in range(DEPTH):
        proj = x @ w_in[l]
        b_g, c_g, u_in, q, kc, vc, ksl, vsl, kwn, vwn, g_lg = jnp.split(proj, offsets, axis=-1)
        conv_out = short_conv_mixer(b_g, c_g, u_in, conv_w[l])
        nsa_out = native_sparse_attention(q, kc, vc, ksl, vsl, kwn, vwn, g_lg,
                                          ck_pos[l], ck_w1[l], ck_b1[l], ck_w2[l],
                                          cv_pos[l], cv_w1[l], cv_b1[l], cv_w2[l])
        mix = jnp.concatenate([conv_out, nsa_out], axis=-1) @ w_out[l]
        x = layer_norm(ALPHA * x + mix, ln1_g[l], ln1_b[l])
        ffn = moe_ffn(x, router_w[l], router_bias[l], w_gate[l], w_up[l], w_down[l],
                      ws_gate[l], ws_up[l], ws_down[l])
        x = layer_norm(ALPHA * x + ffn, ln2_g[l], ln2_b[l])
    return x
```

```cpp
#include <hip/hip_runtime.h>
#include <stdint.h>
#include <stdio.h>

#ifndef N_LAUNCHES
#define N_LAUNCHES 8
#endif

#define LAS __attribute__((address_space(3)))
typedef unsigned short u16;
typedef short bf16x8 __attribute__((ext_vector_type(8)));
typedef short s16x4 __attribute__((ext_vector_type(4)));
typedef short v4i16_t __attribute__((ext_vector_type(4)));
typedef float f32x16 __attribute__((ext_vector_type(16)));
typedef float f32x4 __attribute__((ext_vector_type(4)));
typedef unsigned u32x4 __attribute__((ext_vector_type(4)));
typedef unsigned u32x2 __attribute__((ext_vector_type(2)));
typedef float f32x2_t __attribute__((ext_vector_type(2)));
typedef __bf16 bf16x2_t __attribute__((ext_vector_type(2)));
typedef LAS char* ldsp;

constexpr int T_TOK = 65536, DM = 1024, SEQ = 2048;
constexpr int NPROJ = 2840, NPAD = 2944;
constexpr int C_B = 0, C_C = 512, C_U = 1024, C_Q = 1536, C_KC = 2048, C_VC = 2176, C_KS = 2304, C_VS = 2432, C_KW = 2560, C_VW = 2688, C_GL = 2816;
constexpr float ALPHA = 1.189207115002721f;
constexpr float LOG2E = 1.4426950408889634f;
constexpr float LN_EPS = 1e-5f;
constexpr int NEXP = 256;

constexpr size_t MiB = 1ull << 20;
constexpr size_t WS_BAR = 0;
constexpr size_t WS_CNT = 16384;
constexpr size_t WS_ZERO_BYTES = 32768;
constexpr size_t WS_TOKE = 1 * MiB;
constexpr size_t WS_TOKW = 3 * MiB;
constexpr size_t WS_TOKP = 5 * MiB;
constexpr size_t WS_SSRC = 7 * MiB;
constexpr size_t WS_SW   = 9 * MiB;
constexpr size_t WS_X1H  = 12 * MiB;
constexpr size_t WS_Y    = 140 * MiB;
constexpr size_t WS_END  = WS_Y + 7 * 128 * MiB;
constexpr size_t WS_XB   = 140 * MiB;
constexpr size_t WS_PROJ = 268 * MiB;
constexpr size_t WS_MIX  = 636 * MiB;
constexpr size_t WS_WIN  = 764 * MiB;
constexpr size_t WS_WOUT = 770 * MiB;
constexpr size_t WS_RWH  = 772 * MiB;
constexpr size_t WS_RWL  = 772 * MiB + 512 * 1024;
constexpr size_t WS_CW1  = 773 * MiB;
constexpr size_t WS_CB   = 773 * MiB + 512 * 1024;
constexpr size_t WS_KCMP = 774 * MiB;
constexpr size_t WS_VCMP = 775 * MiB;

constexpr int LDS_BYTES = 147456;
constexpr int LDS_BARW = LDS_BYTES - 16;

__device__ __forceinline__ unsigned cvtpk(float lo, float hi) { f32x2_t v = {lo, hi}; bf16x2_t b = __builtin_convertvector(v, bf16x2_t); return __builtin_bit_cast(unsigned, b); }
__device__ __forceinline__ u16 f2bf(float f) { return (u16)(cvtpk(f, 0.f) & 0xffffu); }
__device__ __forceinline__ float bf2f(u16 b) { return __uint_as_float(((unsigned)b) << 16); }
__device__ __forceinline__ bf16x8 lds_rd128(ldsp p) { return *(LAS bf16x8*)p; }
__device__ __forceinline__ void lds_wr128(ldsp p, bf16x8 v) { *(LAS bf16x8*)p = v; }
__device__ __forceinline__ s16x4 lds_tr(ldsp p) { return __builtin_bit_cast(s16x4, __builtin_amdgcn_ds_read_tr16_b64_v4i16((LAS v4i16_t*)p)); }
__device__ __forceinline__ bf16x8 tr_pair(ldsp p0, ldsp p1) { s16x4 lo = lds_tr(p0), hi = lds_tr(p1); return (bf16x8){lo[0], lo[1], lo[2], lo[3], hi[0], hi[1], hi[2], hi[3]}; }
__device__ __forceinline__ float swap32(float v) { return __shfl_xor(v, 32); }
__device__ __forceinline__ float wave_sum(float v) {
#pragma unroll
    for (int o = 32; o >= 1; o >>= 1) v += __shfl_xor(v, o);
    return v;
}
__device__ __forceinline__ int crow(int r, int h) { return (r & 3) + 8 * (r >> 2) + 4 * h; }
#define VM_WAIT() asm volatile("s_waitcnt vmcnt(0)" ::: "memory")

struct RawF32 { f32x4 a, b; };
__device__ __forceinline__ bf16x8 cvt8(const RawF32& r) {
    u32x4 w; w.x = cvtpk(r.a.x, r.a.y); w.y = cvtpk(r.a.z, r.a.w); w.z = cvtpk(r.b.x, r.b.y); w.w = cvtpk(r.b.z, r.b.w);
    return __builtin_bit_cast(bf16x8, w);
}

template <int N> struct LdBf16 {
    const u16* p[N]; size_t kstep; typedef bf16x8 Raw;
    __device__ __forceinline__ Raw load(int i, int kt) const { return *(const bf16x8*)(p[i] + (size_t)kt * kstep); }
    __device__ __forceinline__ bf16x8 cvt(const Raw& r) const { return r; }
};
template <int N> struct LdF32 {
    const float* p[N]; size_t kstep; typedef RawF32 Raw;
    __device__ __forceinline__ Raw load(int i, int kt) const { const f32x4* q = (const f32x4*)(p[i] + (size_t)kt * kstep); RawF32 r; r.a = q[0]; r.b = q[1]; return r; }
    __device__ __forceinline__ bf16x8 cvt(const Raw& r) const { return cvt8(r); }
};
struct LdCmpA {
    const u16* p; typedef bf16x8 Raw;
    __device__ __forceinline__ Raw load(int, int kt) const { return *(const bf16x8*)(p + (size_t)(kt >> 1) * NPAD + (kt & 1) * 32); }
    __device__ __forceinline__ bf16x8 cvt(const Raw& r) const { return r; }
};
struct LdSplitA {
    const float* p; int mode; typedef RawF32 Raw;
    __device__ __forceinline__ Raw load(int, int kt) const { const f32x4* q = (const f32x4*)(p + kt * 32); RawF32 r; r.a = q[0]; r.b = q[1]; return r; }
    __device__ __forceinline__ bf16x8 cvt(const Raw& r) const {
        if (mode == 0) return cvt8(r);
        RawF32 d;
#pragma unroll
        for (int i = 0; i < 4; ++i) { d.a[i] = r.a[i] - bf2f(f2bf(r.a[i])); d.b[i] = r.b[i] - bf2f(f2bf(r.b[i])); }
        return cvt8(d);
    }
};

template <int BM, int BN, int WM, int WN, bool A_RES, class AL, class BL>
__device__ __forceinline__ void gemm_core(f32x16 (&acc)[BM / (WM * 32)][BN / (WN * 32)], const AL& al, const BL& bl, const int nk, ldsp st, ldsp ares, const int ares_stride) {
    constexpr int MT = BM / (WM * 32), NT = BN / (WN * 32);
    constexpr int NA = A_RES ? 0 : (BM * 4) / 512;
    constexpr int BCH = 32 * (BN / 8);
    constexpr int NBC = (BCH + 511) / 512;
    constexpr int AST = 80, BST = BN * 2 + 64;
    constexpr int ABYTES = A_RES ? 0 : BM * AST, BBYTES = 32 * BST, STAGE = ABYTES + BBYTES;
    static_assert(WM * WN == 8 && (A_RES || BM >= 128), "geometry");
    const int tid = threadIdx.x, lane = tid & 63, wid = tid >> 6;
    const int wm = wid / WN, wn = wid % WN, h = lane >> 5, r32 = lane & 31;
    const int q4 = (lane & 15) >> 2, p4 = lane & 3, g1 = (lane >> 4) & 1;
    const bool bact = (BCH >= 512) || (tid < BCH);
    int adst[NA > 0 ? NA : 1], bdst[NBC];
#pragma unroll
    for (int i = 0; i < NA; ++i) adst[i] = ((tid >> 2) + 128 * i) * AST + (tid & 3) * 16;
#pragma unroll
    for (int i = 0; i < NBC; ++i) { const int q = tid + 512 * i; bdst[i] = ABYTES + (q / (BN / 8)) * BST + (q % (BN / 8)) * 16; }
    const int afrag0 = A_RES ? ((wm * MT * 32 + r32) * ares_stride + h * 16) : ((wm * MT * 32 + r32) * AST + h * 16);
    const int bfrag0 = ABYTES + (8 * h + q4) * BST + (wn * NT * 32 + 16 * g1 + 4 * p4) * 2;
    typename AL::Raw ra[NA > 0 ? NA : 1]; typename BL::Raw rb[NBC];
#pragma unroll
    for (int i = 0; i < NA; ++i) ra[i] = al.load(i, 0);
    if (bact) {
#pragma unroll
        for (int i = 0; i < NBC; ++i) rb[i] = bl.load(i, 0);
    }
#pragma unroll
    for (int i = 0; i < NA; ++i) lds_wr128(st + adst[i], al.cvt(ra[i]));
    if (bact) {
#pragma unroll
        for (int i = 0; i < NBC; ++i) lds_wr128(st + bdst[i], bl.cvt(rb[i]));
    }
    __syncthreads();
    for (int kt = 0; kt < nk; ++kt) {
        ldsp cur = st + (kt & 1) * STAGE, nxt = st + ((kt & 1) ^ 1) * STAGE;
        const bool more = kt + 1 < nk;
        if (more) {
#pragma unroll
            for (int i = 0; i < NA; ++i) ra[i] = al.load(i, kt + 1);
            if (bact) {
#pragma unroll
                for (int i = 0; i < NBC; ++i) rb[i] = bl.load(i, kt + 1);
            }
        }
#pragma unroll
        for (int s = 0; s < 2; ++s) {
            bf16x8 af[MT], bfr[NT];
#pragma unroll
            for (int mt = 0; mt < MT; ++mt)
                af[mt] = A_RES ? lds_rd128(ares + afrag0 + mt * 32 * ares_stride + kt * 64 + s * 32) : lds_rd128(cur + afrag0 + mt * 32 * AST + s * 32);
#pragma unroll
            for (int nt = 0; nt < NT; ++nt)
                bfr[nt] = tr_pair(cur + bfrag0 + (16 * s) * BST + nt * 64, cur + bfrag0 + (16 * s + 4) * BST + nt * 64);
#pragma unroll
            for (int mt = 0; mt < MT; ++mt)
#pragma unroll
                for (int nt = 0; nt < NT; ++nt) acc[mt][nt] = __builtin_amdgcn_mfma_f32_32x32x16_bf16(af[mt], bfr[nt], acc[mt][nt], 0, 0, 0);
        }
        if (more) {
#pragma unroll
            for (int i = 0; i < NA; ++i) lds_wr128(nxt + adst[i], al.cvt(ra[i]));
            if (bact) {
#pragma unroll
                for (int i = 0; i < NBC; ++i) lds_wr128(nxt + bdst[i], bl.cvt(rb[i]));
            }
        }
        __syncthreads();
    }
}

#define XB_TMO      128
#define XB_XCNT(j)  (256  + 64 * (j))
#define XB_XSUB(j)  (1280 + 64 * (j))
#define XB_XGEN(j)  (2304 + 64 * (j))
#define XB_TOP      3328
#define XB_TOPGEN   3392
#define XCD_BAR_WORDS 3456
#define XB_SPIN_CAP (1u << 22)
__device__ __forceinline__ unsigned xb_ld(unsigned* p)              { return __hip_atomic_load(p, __ATOMIC_RELAXED, __HIP_MEMORY_SCOPE_AGENT); }
__device__ __forceinline__ unsigned xb_add(unsigned* p, unsigned v) { return __hip_atomic_fetch_add(p, v, __ATOMIC_RELAXED, __HIP_MEMORY_SCOPE_AGENT); }
__device__ __forceinline__ unsigned xb_xcc_id() { return (unsigned)__builtin_amdgcn_s_getreg((3 << 11) | 20) & 0xFu; }
#define XB_SPIN(cond, bar) do { unsigned _sp = 0; while (cond) { __builtin_amdgcn_s_sleep(1); \
    if ((++_sp & 255u) == 0u) { if (xb_ld(&(bar)[XB_TMO])) break; if (_sp > XB_SPIN_CAP) { atomicAdd(&(bar)[XB_TMO], 1u); break; } } } } while (0)
struct XcdBarrier { unsigned* bar; unsigned x; volatile LAS unsigned* st; };
__device__ __forceinline__ XcdBarrier xcd_barrier_post(unsigned* bar, volatile LAS unsigned* st) {
    XcdBarrier b; b.bar = bar; b.x = xb_xcc_id(); b.st = st;
    if (threadIdx.x == 0) (void)xb_add(&bar[XB_XCNT(b.x)], 1u);
    return b;
}
__device__ __forceinline__ void xcd_barrier_complete(unsigned* bar, unsigned x, unsigned& nloc, unsigned& nx) {
    const unsigned G = gridDim.x * gridDim.y * gridDim.z;
    unsigned sum, cnt, mine, sp = 0u;
    for (;;) {
        sum = 0u; cnt = 0u; mine = 0u;
#pragma unroll
        for (unsigned j = 0; j < 16; ++j) { const unsigned c = xb_ld(&bar[XB_XCNT(j)]); sum += c; cnt += (c > 0u) ? 1u : 0u; mine = (j == x) ? c : mine; }
        if (sum == G) break;
        __builtin_amdgcn_s_sleep(1);
        if ((++sp & 255u) == 0u) { if (xb_ld(&bar[XB_TMO])) break; if (sp > XB_SPIN_CAP) { atomicAdd(&bar[XB_TMO], 1u); break; } }
    }
    nloc = mine > 0u ? mine : 1u; nx = cnt > 0u ? cnt : 1u;
}
__device__ __forceinline__ void xcd_barrier(const XcdBarrier& b) {
    asm volatile("s_waitcnt vmcnt(0)" ::: "memory");
    __syncthreads();
    if (threadIdx.x == 0) {
        unsigned* bar = b.bar;
        __builtin_amdgcn_s_waitcnt(0);
        unsigned nloc = b.st[0], nx = b.st[1];
        if (nloc == 0u) { xcd_barrier_complete(bar, b.x, nloc, nx); b.st[0] = nloc; b.st[1] = nx; }
        const unsigned old = xb_add(&bar[XB_XSUB(b.x)], 1u);
        const unsigned gen = old / nloc;
        if (old + 1u == (gen + 1u) * nloc) {
            __builtin_amdgcn_fence(__ATOMIC_RELEASE, "agent");
            asm volatile("s_waitcnt vmcnt(0)" ::: "memory");
            const unsigned og = xb_add(&bar[XB_TOP], 1u);
            const unsigned tg = og / nx;
            if (og + 1u == (tg + 1u) * nx) xb_add(&bar[XB_TOPGEN], 1u);
            else XB_SPIN(xb_ld(&bar[XB_TOPGEN]) == tg, bar);
            __builtin_amdgcn_fence(__ATOMIC_ACQUIRE, "agent");
            xb_add(&bar[XB_XGEN(b.x)], 1u);
            asm volatile("s_waitcnt vmcnt(0)" ::: "memory");
        } else {
            XB_SPIN(xb_ld(&bar[XB_XGEN(b.x)]) == gen, bar);
            __builtin_amdgcn_fence(__ATOMIC_ACQUIRE, "agent");
            asm volatile("s_waitcnt vmcnt(0)" ::: "memory");
        }
    }
    __syncthreads();
}

struct Args {
    const float* in[24];
    float* out;
    unsigned char* ws;
    int ph_lo, ph_hi;
};

__device__ __forceinline__ void p0_prologue(const Args& A, ldsp L) {
    const int tid = threadIdx.x, G = gridDim.x, bid = blockIdx.x;
    const size_t gt = (size_t)bid * 512 + tid, gs = (size_t)G * 512;
    unsigned char* ws = A.ws;
    {
        const f32x4* src = (const f32x4*)A.in[0]; u32x4* dst = (u32x4*)(ws + WS_XB);
        const size_t n8 = (size_t)T_TOK * DM / 8;
        for (size_t i = gt; i < n8; i += gs) { const f32x4 a = src[2 * i], b = src[2 * i + 1]; u32x4 w; w.x = cvtpk(a.x, a.y); w.y = cvtpk(a.z, a.w); w.z = cvtpk(b.x, b.y); w.w = cvtpk(b.z, b.w); dst[i] = w; }
    }
    {
        const float* w = A.in[1]; u32x4* dst = (u32x4*)(ws + WS_WIN);
        const size_t n8 = (size_t)1024 * (NPAD / 8);
        for (size_t i = gt; i < n8; i += gs) {
            const int k = (int)(i / (NPAD / 8)), c8 = (int)(i % (NPAD / 8));
            u32x4 o = {0u, 0u, 0u, 0u};
            if (c8 * 8 < NPROJ) { const float* s = w + (size_t)k * NPROJ + c8 * 8; o.x = cvtpk(s[0], s[1]); o.y = cvtpk(s[2], s[3]); o.z = cvtpk(s[4], s[5]); o.w = cvtpk(s[6], s[7]); }
            dst[i] = o;
        }
    }
    {
        const f32x4* src = (const f32x4*)A.in[11]; u32x4* dst = (u32x4*)(ws + WS_WOUT);
        const size_t n8 = (size_t)1024 * 1024 / 8;
        for (size_t i = gt; i < n8; i += gs) { const f32x4 a = src[2 * i], b = src[2 * i + 1]; u32x4 w; w.x = cvtpk(a.x, a.y); w.y = cvtpk(a.z, a.w); w.z = cvtpk(b.x, b.y); w.w = cvtpk(b.z, b.w); dst[i] = w; }
    }
    {
        const float* src = A.in[14]; u16* dh = (u16*)(ws + WS_RWH); u16* dl = (u16*)(ws + WS_RWL);
        for (size_t i = gt; i < (size_t)1024 * 256; i += gs) { const float v = src[i]; const u16 hb = f2bf(v); dh[i] = hb; dl[i] = f2bf(v - bf2f(hb)); }
    }
    {
        u16* d = (u16*)(ws + WS_CW1);
        for (size_t i = gt; i < (size_t)2 * 2048 * 64; i += gs) { const int kv = (int)(i >> 17); const size_t r = i & 131071; d[i] = f2bf((kv ? A.in[8] : A.in[4])[r]); }
    }
    {
        u16* kc = (u16*)(ws + WS_KCMP); u16* vc = (u16*)(ws + WS_VCMP);
        for (size_t i = gt; i < (size_t)32 * 128; i += gs) { const int b = (int)(i >> 7), r = (int)(i & 127); kc[((size_t)(b * 128 + 127) * 2) * 64 + r] = 0; vc[((size_t)(b * 128 + 127) * 2) * 64 + r] = 0; }
    }
    if (bid == 0) {
        LAS float* part = (LAS float*)L;
        const int o = tid & 127, prt = tid >> 7, kv = o >> 6, n = o & 63;
        const float* pos = kv ? A.in[7] : A.in[3]; const float* w1 = kv ? A.in[8] : A.in[4];
        float s = 0.f;
        for (int kk = prt * 512; kk < prt * 512 + 512; ++kk) s += pos[kk] * w1[(size_t)kk * 64 + n];
        part[prt * 128 + o] = s;
        __syncthreads();
        if (tid < 128) { const float* b1 = kv ? A.in[9] : A.in[5]; ((float*)(ws + WS_CB))[tid] = part[tid] + part[128 + tid] + part[256 + tid] + part[384 + tid] + b1[n]; }
        __syncthreads();
    }
}

__device__ __forceinline__ void p1_proj(const Args& A, ldsp L, int vcu, int G) {
    const int tid = threadIdx.x, lane = tid & 63, wid = tid >> 6, h = lane >> 5, r32 = lane & 31;
    const u16* xb = (const u16*)(A.ws + WS_XB); const u16* wp = (const u16*)(A.ws + WS_WIN); u16* proj = (u16*)(A.ws + WS_PROJ);
    constexpr int NTN = NPAD / 128;
    const int wm = wid >> 1, wn = wid & 1;
    for (int u = vcu; u < (T_TOK / 256) * NTN; u += G) {
        const int pm = u / NTN, pn = u % NTN, m0 = pm * 256, n0 = pn * 128;
        LdBf16<2> al; al.kstep = 32;
        al.p[0] = xb + (size_t)(m0 + (tid >> 2)) * DM + (tid & 3) * 8; al.p[1] = al.p[0] + (size_t)128 * DM;
        LdBf16<1> bl; bl.kstep = (size_t)32 * NPAD;
        bl.p[0] = wp + (size_t)(tid >> 4) * NPAD + n0 + (tid & 15) * 8;
        f32x16 acc[2][2];
#pragma unroll
        for (int i = 0; i < 2; ++i)
#pragma unroll
            for (int j = 0; j < 2; ++j) acc[i][j] = f32x16{};
        gemm_core<256, 128, 4, 2, false>(acc, al, bl, DM / 32, L, L, 0);
#pragma unroll
        for (int mt = 0; mt < 2; ++mt)
#pragma unroll
            for (int nt = 0; nt < 2; ++nt)
#pragma unroll
                for (int r = 0; r < 16; ++r) {
                    const int row = m0 + wm * 64 + mt * 32 + crow(r, h), col = n0 + wn * 64 + nt * 32 + r32;
                    proj[(size_t)row * NPAD + col] = f2bf(acc[mt][nt][r]);
                }
    }
}

__device__ __forceinline__ float gelu_tanh(float x) { const float u = 0.7978845608028654f * (x + 0.044715f * x * x * x); return 0.5f * x * (1.f + tanhf(u)); }
__device__ __forceinline__ void p2_compress(const Args& A, ldsp L, int bid, int G) {
    const int tid = threadIdx.x, lane = tid & 63, wid = tid >> 6, h = lane >> 5, r32 = lane & 31;
    const u16* proj = (const u16*)(A.ws + WS_PROJ);
    const int wm = wid >> 1, wn = wid & 1;
    for (int u = bid; u < 128; u += G) {
        const int kv = u >> 6, r0 = (u & 63) * 128;
        int rr = r0 + (tid >> 2); if (rr > 8127) rr = 8127;
        const int b = rr / 254, rem = rr % 254, ci = rem >> 1, g = rem & 1;
        LdCmpA al; al.p = proj + (size_t)(b * SEQ + 16 * ci) * NPAD + (kv ? C_VC : C_KC) + g * 64 + (tid & 3) * 8;
        LdBf16<1> bl; bl.kstep = 32 * 64;
        bl.p[0] = (const u16*)(A.ws + WS_CW1) + (size_t)kv * 2048 * 64 + (size_t)((tid & 255) >> 3) * 64 + (tid & 7) * 8;
        f32x16 acc[1][1]; acc[0][0] = f32x16{};
        gemm_core<128, 64, 4, 2, false>(acc, al, bl, 2048 / 32, L, L, 0);
        LAS float* hid = (LAS float*)(L + 32768);
        const float* cb = (const float*)(A.ws + WS_CB) + kv * 64;
#pragma unroll
        for (int r = 0; r < 16; ++r) { const int row = wm * 32 + crow(r, h), col = wn * 32 + r32; hid[row * 65 + col] = gelu_tanh(acc[0][0][r] + cb[col]); }
        __syncthreads();
        {
            const int row = tid >> 2, qd = tid & 3;
            const float* w2 = kv ? A.in[10] : A.in[6];
            float o[16];
#pragma unroll
            for (int j = 0; j < 16; ++j) o[j] = 0.f;
            for (int n = 0; n < 64; ++n) { const float hv = hid[row * 65 + n]; const float* wr = w2 + n * 64 + qd * 16;
#pragma unroll
                for (int j = 0; j < 16; ++j) o[j] += hv * wr[j]; }
            const int r2 = r0 + row;
            if (r2 < 8128) {
                const int b2 = r2 / 254, rem2 = r2 % 254, ci2 = rem2 >> 1, g2 = rem2 & 1;
                u16* dst = (u16*)(A.ws + (kv ? WS_VCMP : WS_KCMP)) + ((size_t)(b2 * 128 + ci2) * 2 + g2) * 64 + qd * 16;
                u32x4 w0, w1;
                w0.x = cvtpk(o[0], o[1]); w0.y = cvtpk(o[2], o[3]); w0.z = cvtpk(o[4], o[5]); w0.w = cvtpk(o[6], o[7]);
                w1.x = cvtpk(o[8], o[9]); w1.y = cvtpk(o[10], o[11]); w1.z = cvtpk(o[12], o[13]); w1.w = cvtpk(o[14], o[15]);
                *(u32x4*)dst = w0; *(u32x4*)(dst + 8) = w1;
            }
        }
        __syncthreads();
    }
}

constexpr int L3_KC = 0, L3_VC = 18432, L3_BUF = 0, L3_BUFSZ = 21504, L3_E = 43008, L3_F = 75776, L3_IMP = 108544, L3_SEL = 116736, L3_UNI = 116992, L3_JOBS = 117008, L3_NJOB = 117264;
constexpr float NEGBIG = -1e30f;

__device__ __forceinline__ void p3_unit(const Args& A, ldsp L, const int b, const int g, const int qt, const int zlaunder) {
    const int tid = threadIdx.x + zlaunder, lane = tid & 63, wid = tid >> 6, h = lane >> 5, r32 = lane & 31;
    const int q4 = (lane & 15) >> 2, p4 = lane & 3, g1 = (lane >> 4) & 1;
    const u16* proj = (const u16*)(A.ws + WS_PROJ);
    u16* mix = (u16*)(A.ws + WS_MIX);
    const int r = wid >> 1, qh = wid & 1, head = g * 4 + r;
    const int ql = qh * 32 + r32, tq = qt * 64 + ql;
    const size_t trow = (size_t)b * SEQ + tq;
    const float slope2 = exp2f(-(float)(head + 1)) * LOG2E, sc2 = 0.125f * LOG2E;
    LAS unsigned* selm = (LAS unsigned*)(L + L3_SEL);
    LAS unsigned* uni = (LAS unsigned*)(L + L3_UNI);
    LAS int* jobs = (LAS int*)(L + L3_JOBS);
    LAS int* njobp = (LAS int*)(L + L3_NJOB);
    if (tid == 0) uni[0] = 0u;
    bf16x8 qf[4];
#pragma unroll
    for (int s = 0; s < 4; ++s) qf[s] = *(const bf16x8*)(proj + trow * NPAD + C_Q + head * 64 + 16 * s + 8 * h);
    float gate[3];
#pragma unroll
    for (int i = 0; i < 3; ++i) { const float x = bf2f(proj[trow * NPAD + C_GL + head * 3 + i]); gate[i] = 1.f / (1.f + __expf(-x)); }
    {
        const u16* kc = (const u16*)(A.ws + WS_KCMP); const u16* vc = (const u16*)(A.ws + WS_VCMP);
#pragma unroll
        for (int i = 0; i < 2; ++i) {
            const int c = tid + 512 * i, n = c >> 3, ch = c & 7;
            const size_t so = ((size_t)(b * 128 + n) * 2 + g) * 64 + ch * 8;
            lds_wr128(L + L3_KC + n * 144 + ch * 16, *(const bf16x8*)(kc + so));
            lds_wr128(L + L3_VC + n * 192 + ch * 16, *(const bf16x8*)(vc + so));
        }
    }
    __syncthreads();
    f32x16 otot[2]; otot[0] = f32x16{}; otot[1] = f32x16{};
    {
        f32x16 sc[4];
        float m = NEGBIG;
#pragma unroll
        for (int kt = 0; kt < 4; ++kt) {
            sc[kt] = f32x16{};
#pragma unroll
            for (int s = 0; s < 4; ++s) sc[kt] = __builtin_amdgcn_mfma_f32_32x32x16_bf16(lds_rd128(L + L3_KC + (kt * 32 + r32) * 144 + (2 * s + h) * 16), qf[s], sc[kt], 0, 0, 0);
#pragma unroll
            for (int rg = 0; rg < 16; ++rg) {
                const int n = kt * 32 + crow(rg, h); const int dist = tq - (16 * n + 31);
                const bool valid = (dist >= 0) && (n < 127);
                const float v = sc[kt][rg] * sc2 - slope2 * (float)dist;
                sc[kt][rg] = valid ? v : NEGBIG;
                m = fmaxf(m, sc[kt][rg]);
            }
            __builtin_amdgcn_sched_barrier(0);
        }
        m = fmaxf(m, swap32(m));
        float l = 0.f;
#pragma unroll
        for (int kt = 0; kt < 4; ++kt)
#pragma unroll
            for (int rg = 0; rg < 16; ++rg) { const float p = (sc[kt][rg] > -1e29f) ? __builtin_amdgcn_exp2f(sc[kt][rg] - m) : 0.f; sc[kt][rg] = p; l += p; }
        l += swap32(l);
        const float inv = l > 0.f ? 1.f / l : 0.f;
        LAS float* E = (LAS float*)(L + L3_E) + (r * 64 + ql) * 32;
        LAS float* F = (LAS float*)(L + L3_F) + (r * 64 + ql) * 32;
        if (h == 0) F[0] = 0.f;
#pragma unroll
        for (int kt = 0; kt < 4; ++kt)
#pragma unroll
            for (int gq = 0; gq < 4; ++gq) {
                const float p0 = sc[kt][4 * gq] * inv, p1 = sc[kt][4 * gq + 1] * inv, p2 = sc[kt][4 * gq + 2] * inv, p3 = sc[kt][4 * gq + 3] * inv;
                sc[kt][4 * gq] = p0; sc[kt][4 * gq + 1] = p1; sc[kt][4 * gq + 2] = p2; sc[kt][4 * gq + 3] = p3;
                const int j = 8 * kt + 2 * gq + h;
                E[j] = (p0 + p1) + (p2 + p3);
                if (j + 1 < 32) F[j + 1] = p3;
            }
        f32x16 o[2]; o[0] = f32x16{}; o[1] = f32x16{};
#pragma unroll
        for (int ks = 0; ks < 8; ++ks) {
            const int kt = ks >> 1, sb = (ks & 1) * 8;
            u32x4 pw; pw.x = cvtpk(sc[kt][sb], sc[kt][sb + 1]); pw.y = cvtpk(sc[kt][sb + 2], sc[kt][sb + 3]); pw.z = cvtpk(sc[kt][sb + 4], sc[kt][sb + 5]); pw.w = cvtpk(sc[kt][sb + 6], sc[kt][sb + 7]);
            const bf16x8 pf = __builtin_bit_cast(bf16x8, pw);
#pragma unroll
            for (int dt = 0; dt < 2; ++dt) {
                ldsp vp = L + L3_VC + (16 * ks + 4 * h + q4) * 192 + (dt * 32 + 16 * g1 + 4 * p4) * 2;
                o[dt] = __builtin_amdgcn_mfma_f32_32x32x16_bf16(tr_pair(vp, vp + 8 * 192), pf, o[dt], 0, 0, 0);
            }
        }
#pragma unroll
        for (int dt = 0; dt < 2; ++dt)
#pragma unroll
            for (int rg = 0; rg < 16; ++rg) otot[dt][rg] = gate[0] * o[dt][rg];
    }
    __syncthreads();
    {
        const int qq = tid >> 3, sub = tid & 7;
        LAS float* impl = (LAS float*)(L + L3_IMP);
#pragma unroll
        for (int jj = 0; jj < 4; ++jj) {
            const int j = sub * 4 + jj; float s = 0.f;
#pragma unroll
            for (int rr = 0; rr < 4; ++rr) s += ((LAS float*)(L + L3_E))[(rr * 64 + qq) * 32 + j] + ((LAS float*)(L + L3_F))[(rr * 64 + qq) * 32 + j];
            impl[qq * 32 + j] = s;
        }
        __syncthreads();
        const int nfree = 8 - (qt == 0 ? 1 : 2);
        unsigned mk = 0u;
#pragma unroll
        for (int jj = 0; jj < 4; ++jj) {
            const int j = sub * 4 + jj;
            if (j == 0 || j == qt) mk |= 1u << j;
            else if (j < qt) {
                const float mine = impl[qq * 32 + j]; int rank = 0;
                for (int j2 = 1; j2 < qt; ++j2) { const float o2 = impl[qq * 32 + j2]; rank += (o2 > mine || (o2 == mine && j2 < j)) ? 1 : 0; }
                if (rank < nfree) mk |= 1u << j;
            }
        }
        mk |= __shfl_xor(mk, 1); mk |= __shfl_xor(mk, 2); mk |= __shfl_xor(mk, 4);
        if (sub == 0) { selm[qq] = mk; atomicOr((unsigned*)uni, mk); }
        __syncthreads();
        if (tid == 0) {
            const unsigned um = uni[0]; int n = 0;
            for (int j = 0; j <= qt; ++j) if ((um >> j) & 1u) jobs[n++] = (1 << 8) | j;
            for (int j = (qt >= 8 ? qt - 8 : 0); j <= qt; ++j) jobs[n++] = (2 << 8) | j;
            njobp[0] = n;
        }
        __syncthreads();
    }
    {
        const int njob = __builtin_amdgcn_readfirstlane(njobp[0]);
        const unsigned mysel = selm[ql];
        const int lrow = tid >> 3, lch = tid & 7;
        float m = NEGBIG, l = 0.f; f32x16 o[2]; o[0] = f32x16{}; o[1] = f32x16{};
        int curkind = 1;
        bf16x8 kreg, vreg;
        {
            const int jb = __builtin_amdgcn_readfirstlane(jobs[0]), kind = jb >> 8, j = jb & 255;
            const u16* src = proj + ((size_t)b * SEQ + 64 * j + lrow) * NPAD + g * 64 + lch * 8;
            kreg = *(const bf16x8*)(src + (kind == 1 ? C_KS : C_KW)); vreg = *(const bf16x8*)(src + (kind == 1 ? C_VS : C_VW));
        }
        lds_wr128(L + L3_BUF + lrow * 144 + lch * 16, kreg);
        lds_wr128(L + L3_BUF + 9216 + lrow * 192 + lch * 16, vreg);
        __syncthreads();
#pragma unroll 1
        for (int i = 0; i < njob; ++i) {
            const bool more = i + 1 < njob;
            if (more) {
                const int jb = __builtin_amdgcn_readfirstlane(jobs[i + 1]), kind = jb >> 8, j = jb & 255;
                const u16* src = proj + ((size_t)b * SEQ + 64 * j + lrow) * NPAD + g * 64 + lch * 8;
                kreg = *(const bf16x8*)(src + (kind == 1 ? C_KS : C_KW)); vreg = *(const bf16x8*)(src + (kind == 1 ? C_VS : C_VW));
            }
            const int jb = __builtin_amdgcn_readfirstlane(jobs[i]), kind = jb >> 8, j = jb & 255;
            if (kind != curkind) {
                const float f = gate[1] * (l > 0.f ? 1.f / l : 0.f);
#pragma unroll
                for (int dt = 0; dt < 2; ++dt)
#pragma unroll
                    for (int rg = 0; rg < 16; ++rg) { otot[dt][rg] += f * o[dt][rg]; o[dt][rg] = 0.f; }
                m = NEGBIG; l = 0.f; curkind = kind;
            }
            ldsp Kb = L + L3_BUF + (i & 1) * L3_BUFSZ, Vb = Kb + 9216;
            const bool wsel = (mysel >> j) & 1u;
            const bool active = (kind == 2) || (__any(wsel) != 0);
            if (active) {
                f32x16 s0 = f32x16{}, s1 = f32x16{};
#pragma unroll
                for (int s = 0; s < 4; ++s) {
                    s0 = __builtin_amdgcn_mfma_f32_32x32x16_bf16(lds_rd128(Kb + r32 * 144 + (2 * s + h) * 16), qf[s], s0, 0, 0, 0);
                    s1 = __builtin_amdgcn_mfma_f32_32x32x16_bf16(lds_rd128(Kb + (32 + r32) * 144 + (2 * s + h) * 16), qf[s], s1, 0, 0, 0);
                }
                float mb = NEGBIG;
#pragma unroll
                for (int rg = 0; rg < 16; ++rg) {
                    const int d0 = tq - (64 * j + crow(rg, h)), d1 = d0 - 32;
                    const bool v0 = (kind == 1) ? (wsel && d0 >= 0) : (d0 >= 0 && d0 < 512);
                    const bool v1 = (kind == 1) ? (wsel && d1 >= 0) : (d1 >= 0 && d1 < 512);
                    s0[rg] = v0 ? (s0[rg] * sc2 - slope2 * (float)d0) : NEGBIG;
                    s1[rg] = v1 ? (s1[rg] * sc2 - slope2 * (float)d1) : NEGBIG;
                    mb = fmaxf(mb, fmaxf(s0[rg], s1[rg]));
                }
                mb = fmaxf(mb, swap32(mb));
                const float mnew = fmaxf(m, mb);
                const float alpha = __builtin_amdgcn_exp2f(m - mnew);
                float ls = 0.f;
#pragma unroll
                for (int rg = 0; rg < 16; ++rg) {
                    const float p0 = (s0[rg] > -1e29f) ? __builtin_amdgcn_exp2f(s0[rg] - mnew) : 0.f;
                    const float p1 = (s1[rg] > -1e29f) ? __builtin_amdgcn_exp2f(s1[rg] - mnew) : 0.f;
                    s0[rg] = p0; s1[rg] = p1; ls += p0 + p1;
                }
                ls += swap32(ls);
                l = l * alpha + ls; m = mnew;
#pragma unroll
                for (int dt = 0; dt < 2; ++dt)
#pragma unroll
                    for (int rg = 0; rg < 16; ++rg) o[dt][rg] *= alpha;
#pragma unroll
                for (int ks = 0; ks < 4; ++ks) {
                    const int sb = (ks & 1) * 8;
                    u32x4 pw;
                    if (ks < 2) { pw.x = cvtpk(s0[sb], s0[sb + 1]); pw.y = cvtpk(s0[sb + 2], s0[sb + 3]); pw.z = cvtpk(s0[sb + 4], s0[sb + 5]); pw.w = cvtpk(s0[sb + 6], s0[sb + 7]); }
                    else        { pw.x = cvtpk(s1[sb], s1[sb + 1]); pw.y = cvtpk(s1[sb + 2], s1[sb + 3]); pw.z = cvtpk(s1[sb + 4], s1[sb + 5]); pw.w = cvtpk(s1[sb + 6], s1[sb + 7]); }
                    const bf16x8 pf = __builtin_bit_cast(bf16x8, pw);
#pragma unroll
                    for (int dt = 0; dt < 2; ++dt) {
                        ldsp vp = Vb + (16 * ks + 4 * h + q4) * 192 + (dt * 32 + 16 * g1 + 4 * p4) * 2;
                        o[dt] = __builtin_amdgcn_mfma_f32_32x32x16_bf16(tr_pair(vp, vp + 8 * 192), pf, o[dt], 0, 0, 0);
                    }
                }
            }
            if (more) {
                ldsp Kn = L + L3_BUF + ((i + 1) & 1) * L3_BUFSZ;
                lds_wr128(Kn + lrow * 144 + lch * 16, kreg);
                lds_wr128(Kn + 9216 + lrow * 192 + lch * 16, vreg);
            }
            __syncthreads();
        }
        {
            const float f = gate[2] * (l > 0.f ? 1.f / l : 0.f);
#pragma unroll
            for (int dt = 0; dt < 2; ++dt)
#pragma unroll
                for (int rg = 0; rg < 16; ++rg) otot[dt][rg] += f * o[dt][rg];
        }
    }
#pragma unroll
    for (int dt = 0; dt < 2; ++dt)
#pragma unroll
        for (int gq = 0; gq < 4; ++gq) {
            u32x2 w; w.x = cvtpk(otot[dt][4 * gq], otot[dt][4 * gq + 1]); w.y = cvtpk(otot[dt][4 * gq + 2], otot[dt][4 * gq + 3]);
            *(u32x2*)(mix + trow * DM + 512 + head * 64 + dt * 32 + 8 * gq + 4 * h) = w;
        }
    {
        const int cc = tid & 31, tg = tid >> 5;
        const int ch0 = g * 256 + cc * 8;
        const float* cw = A.in[2];
        float w0[8], w1[8], w2[8];
#pragma unroll
        for (int e = 0; e < 8; ++e) { w0[e] = cw[ch0 + e]; w1[e] = cw[512 + ch0 + e]; w2[e] = cw[1024 + ch0 + e]; }
        float cu[6][8];
#pragma unroll
        for (int i = 0; i < 6; ++i) {
            const int t = qt * 64 + tg * 4 + i - 2;
            if (t >= 0) {
                const u16* pr = proj + ((size_t)b * SEQ + t) * NPAD;
                const bf16x8 cv = *(const bf16x8*)(pr + C_C + ch0), uv = *(const bf16x8*)(pr + C_U + ch0);
#pragma unroll
                for (int e = 0; e < 8; ++e) cu[i][e] = bf2f((u16)cv[e]) * bf2f((u16)uv[e]);
            } else {
#pragma unroll
                for (int e = 0; e < 8; ++e) cu[i][e] = 0.f;
            }
        }
#pragma unroll
        for (int i = 0; i < 4; ++i) {
            const int t = qt * 64 + tg * 4 + i;
            const bf16x8 bv = *(const bf16x8*)(proj + ((size_t)b * SEQ + t) * NPAD + C_B + ch0);
            float y[8];
#pragma unroll
            for (int e = 0; e < 8; ++e) y[e] = bf2f((u16)bv[e]) * (w0[e] * cu[i][e] + w1[e] * cu[i + 1][e] + w2[e] * cu[i + 2][e]);
            u32x4 w; w.x = cvtpk(y[0], y[1]); w.y = cvtpk(y[2], y[3]); w.z = cvtpk(y[4], y[5]); w.w = cvtpk(y[6], y[7]);
            *(u32x4*)(mix + ((size_t)b * SEQ + t) * DM + ch0) = w;
        }
    }
}

__device__ __forceinline__ void p4_unit(const Args& A, ldsp L, const int panel) {
    const int tid = threadIdx.x, lane = tid & 63, wid = tid >> 6, h = lane >> 5, r32 = lane & 31;
    const int wm = wid >> 2, wn = wid & 3;
    const int m0 = panel * 128;
    const u16* mix = (const u16*)(A.ws + WS_MIX);
    float* ybuf = A.out;
    const float* x = A.in[0];
#pragma unroll 1
    for (int nc = 0; nc < 4; ++nc) {
        LdBf16<1> al; al.kstep = 32; al.p[0] = mix + (size_t)(m0 + (tid >> 2)) * DM + (tid & 3) * 8;
        LdBf16<2> bl; bl.kstep = (size_t)32 * DM;
        bl.p[0] = (const u16*)(A.ws + WS_WOUT) + (size_t)(tid >> 5) * DM + nc * 256 + (tid & 31) * 8; bl.p[1] = bl.p[0] + (size_t)16 * DM;
        f32x16 acc[2][2];
#pragma unroll
        for (int i = 0; i < 2; ++i)
#pragma unroll
            for (int j = 0; j < 2; ++j) acc[i][j] = f32x16{};
        gemm_core<128, 256, 2, 4, false>(acc, al, bl, DM / 32, L, L, 0);
        {
            LAS float* Tl = (LAS float*)L + (wm * 64 + 4 * h) * 260 + wn * 64 + r32;
#pragma unroll
            for (int mt = 0; mt < 2; ++mt)
#pragma unroll
                for (int nt = 0; nt < 2; ++nt)
#pragma unroll
                    for (int r = 0; r < 16; ++r) Tl[(mt * 32 + (r & 3) + 8 * (r >> 2)) * 260 + nt * 32] = acc[mt][nt][r];
            __syncthreads();
#pragma unroll 4
            for (int i = 0; i < 16; ++i) {
                const int idx = i * 512 + tid, row = idx >> 6, c4 = idx & 63;
                const f32x4 a = *(LAS f32x4*)((LAS float*)L + row * 260 + c4 * 4);
                const size_t gi = (size_t)(m0 + row) * DM + nc * 256 + c4 * 4;
                const f32x4 xv = *(const f32x4*)(x + gi);
                *(f32x4*)(ybuf + gi) = a + ALPHA * xv;
            }
            __syncthreads();
        }
    }
    VM_WAIT();
    __syncthreads();
    {
        const float* gam = A.in[12]; const float* bet = A.in[13];
        u16* x1h = (u16*)(A.ws + WS_X1H);
#pragma unroll 1
        for (int rr = 0; rr < 16; ++rr) {
            const size_t row = (size_t)m0 + wid * 16 + rr;
            f32x4 v[4]; float s = 0.f;
#pragma unroll
            for (int jj = 0; jj < 4; ++jj) { v[jj] = *(const f32x4*)(ybuf + row * DM + lane * 4 + 256 * jj); s += (v[jj].x + v[jj].y) + (v[jj].z + v[jj].w); }
            const float mean = wave_sum(s) * (1.f / 1024.f);
            float q = 0.f;
#pragma unroll
            for (int jj = 0; jj < 4; ++jj) { v[jj] = v[jj] - mean; q += (v[jj].x * v[jj].x + v[jj].y * v[jj].y) + (v[jj].z * v[jj].z + v[jj].w * v[jj].w); }
            const float rstd = rsqrtf(wave_sum(q) * (1.f / 1024.f) + LN_EPS);
#pragma unroll
            for (int jj = 0; jj < 4; ++jj) {
                const int c = lane * 4 + 256 * jj;
                const f32x4 gg = *(const f32x4*)(gam + c), bb = *(const f32x4*)(bet + c);
                const f32x4 o = v[jj] * rstd * gg + bb;
                *(f32x4*)(ybuf + row * DM + c) = o;
                u32x2 w; w.x = cvtpk(o.x, o.y); w.y = cvtpk(o.z, o.w);
                *(u32x2*)(x1h + row * DM + c) = w;
            }
        }
    }
    VM_WAIT();
    __syncthreads();
    {
        f32x16 acc[2][2];
#pragma unroll
        for (int i = 0; i < 2; ++i)
#pragma unroll
            for (int j = 0; j < 2; ++j) acc[i][j] = f32x16{};
#pragma unroll 1
        for (int pass = 0; pass < 3; ++pass) {
            LdSplitA al; al.p = ybuf + (size_t)(m0 + (tid >> 2)) * DM + (tid & 3) * 8; al.mode = (pass == 2) ? 1 : 0;
            LdBf16<2> bl; bl.kstep = (size_t)32 * 256;
            bl.p[0] = (const u16*)(A.ws + (pass == 1 ? WS_RWL : WS_RWH)) + (size_t)(tid >> 5) * 256 + (tid & 31) * 8; bl.p[1] = bl.p[0] + (size_t)16 * 256;
            gemm_core<128, 256, 2, 4, false>(acc, al, bl, DM / 32, L, L, 0);
        }
        LAS float* lg = (LAS float*)L;
#pragma unroll
        for (int mt = 0; mt < 2; ++mt)
#pragma unroll
            for (int nt = 0; nt < 2; ++nt)
#pragma unroll
                for (int r = 0; r < 16; ++r) lg[(wm * 64 + mt * 32 + crow(r, h)) * 257 + wn * 64 + nt * 32 + r32] = acc[mt][nt][r];
    }
    LAS int* hist = (LAS int*)(L + 131584);
    LAS int* ubase = (LAS int*)(L + 131584 + 1024);
    LAS int* rowe = (LAS int*)(L + 131584 + 2048);
    LAS int* rowr = (LAS int*)(L + 131584 + 2048 + 4096);
    if (tid < 256) hist[tid] = 0;
    __syncthreads();
    {
        const float* rbias = A.in[15];
        LAS float* lg = (LAS float*)L;
        int* tok_e = (int*)(A.ws + WS_TOKE); float* tok_w = (float*)(A.ws + WS_TOKW);
#pragma unroll 1
        for (int pass = 0; pass < 2; ++pass) {
            const int row = pass * 64 + (tid >> 3), gi = tid & 7;
            const size_t tok = (size_t)m0 + row;
            float bv[32];
            float m1 = -INFINITY, m2 = -INFINITY;
#pragma unroll
            for (int e = 0; e < 32; ++e) {
                const float sg = 1.f / (1.f + expf(-lg[row * 257 + gi * 32 + e]));
                const float v = sg + rbias[gi * 32 + e];
                bv[e] = v;
                if (v > m1) { m2 = m1; m1 = v; } else if (v > m2) m2 = v;
            }
            const float gs = m1 + m2;
            int rank = 0;
#pragma unroll
            for (int j = 0; j < 8; ++j) { const float o2 = __shfl(gs, (lane & ~7) | j); rank += (o2 > gs || (o2 == gs && j < gi)) ? 1 : 0; }
            const bool gsel = rank < 4;
            unsigned taken = 0u;
            int esel[8];
#pragma unroll
            for (int k = 0; k < 8; ++k) {
                float bvv = -INFINITY; int bi = 1 << 20;
                if (gsel) {
#pragma unroll
                    for (int e = 0; e < 32; ++e) { const bool ok = !((taken >> e) & 1u) && bv[e] > bvv; bvv = ok ? bv[e] : bvv; bi = ok ? (gi * 32 + e) : bi; }
                }
#pragma unroll
                for (int o = 1; o < 8; o <<= 1) {
                    const float ov = __shfl_xor(bvv, o); const int oi = __shfl_xor(bi, o);
                    const bool tk = (ov > bvv) || (ov == bvv && oi < bi);
                    bvv = tk ? ov : bvv; bi = tk ? oi : bi;
                }
                if ((bi >> 5) == gi) taken |= 1u << (bi & 31);
                esel[k] = bi;
            }
            if (gi == 0) {
                float sc[8], ssum = 0.f;
#pragma unroll
                for (int k = 0; k < 8; ++k) { sc[k] = 1.f / (1.f + expf(-lg[row * 257 + esel[k]])); ssum += sc[k]; }
#pragma unroll
                for (int k = 0; k < 8; ++k) {
                    tok_e[tok * 8 + k] = esel[k]; tok_w[tok * 8 + k] = sc[k] / ssum * 2.5f;
                    rowe[row * 8 + k] = esel[k];
                    rowr[row * 8 + k] = atomicAdd((int*)&hist[esel[k]], 1);
                }
            }
        }
    }
    __syncthreads();
    if (tid < 256) { const int c = hist[tid]; ubase[tid] = c ? atomicAdd((int*)(A.ws + WS_CNT) + tid, c) : 0; }
    __syncthreads();
    {
        int* tok_p = (int*)(A.ws + WS_TOKP);
        for (int i = tid; i < 1024; i += 512) tok_p[(size_t)m0 * 8 + i] = ubase[rowe[i]] + rowr[i];
    }
    __syncthreads();
}

__device__ __forceinline__ void p5_fill(const Args& A, ldsp L, int bid, int G) {
    const int tid = threadIdx.x;
    LAS int* base = (LAS int*)L;
    const int* cnt = (const int*)(A.ws + WS_CNT);
    if (tid == 0) { int s = 0; for (int e = 0; e < NEXP; ++e) { base[e] = s; s += cnt[e]; } }
    __syncthreads();
    const int* tok_e = (const int*)(A.ws + WS_TOKE); const float* tok_w = (const float*)(A.ws + WS_TOKW); const int* tok_p = (const int*)(A.ws + WS_TOKP);
    int* ssrc = (int*)(A.ws + WS_SSRC); float* sw = (float*)(A.ws + WS_SW);
    for (size_t i = (size_t)bid * 512 + tid; i < (size_t)T_TOK * 8; i += (size_t)G * 512) {
        const int d = base[tok_e[i]] + tok_p[i];
        ssrc[d] = (int)i; sw[d] = tok_w[i];
    }
    __syncthreads();
}

__device__ __forceinline__ void p6_moe(const Args& A, ldsp L, int vcu, int G) {
    const int tid = threadIdx.x, lane = tid & 63, wid = tid >> 6, h = lane >> 5, r32 = lane & 31;
    const int wm = wid >> 2, wn = wid & 3;
    constexpr int HST = 528;
    ldsp Hl = L + 57344;
    LAS int* tstart = (LAS int*)(L + 126464);
    LAS int* ebase = (LAS int*)(L + 126464 + 1040);
    LAS int* rtok = (LAS int*)(L + 124928);
    LAS int* rsrc = (LAS int*)(L + 124928 + 512);
    LAS float* rwt = (LAS float*)(L + 124928 + 1024);
    const int* cnt = (const int*)(A.ws + WS_CNT);
    if (tid == 0) { int s = 0, t = 0; for (int e = 0; e < NEXP; ++e) { ebase[e] = s; tstart[e] = t; s += cnt[e]; t += (cnt[e] + 127) >> 7; } tstart[NEXP] = t; }
    __syncthreads();
    const int nrt = tstart[NEXP], ntiles = nrt + T_TOK / 128;
    const int* ssrc = (const int*)(A.ws + WS_SSRC); const float* sw = (const float*)(A.ws + WS_SW);
    const u16* x1h = (const u16*)(A.ws + WS_X1H);
    for (int tile = vcu; tile < ntiles; tile += G) {
        int e, r0, nrows;
        if (tile < nrt) { int lo = 0, hi = NEXP - 1; while (lo < hi) { const int mid = (lo + hi + 1) >> 1; if (tstart[mid] <= tile) lo = mid; else hi = mid - 1; } e = lo; r0 = (tile - tstart[e]) * 128; nrows = cnt[e] - r0; if (nrows > 128) nrows = 128; }
        else { e = NEXP; r0 = (tile - nrt) * 128; nrows = 128; }
        if (tid < 128) {
            int tk, sr; float w;
            if (e < NEXP) { const int rr = tid < nrows ? tid : 0; const int s = ssrc[ebase[e] + r0 + rr]; tk = s >> 3; sr = tid < nrows ? (tk * 16 + (s & 7)) : -1; w = tid < nrows ? sw[ebase[e] + r0 + rr] : 0.f; }
            else { tk = r0 + tid; sr = tk * 16 + 8; w = 1.f; }
            rtok[tid] = tk; rsrc[tid] = sr; rwt[tid] = w;
        }
        __syncthreads();
        const float* wg = e < NEXP ? A.in[16] + (size_t)e * 1024 * 256 : A.in[19];
        const float* wu = e < NEXP ? A.in[17] + (size_t)e * 1024 * 256 : A.in[20];
        const float* wd = e < NEXP ? A.in[18] + (size_t)e * 256 * 1024 : A.in[21];
#pragma unroll 1
        for (int c = 0; c < 2; ++c) {
            LdBf16<1> al; al.kstep = 32; al.p[0] = x1h + (size_t)rtok[tid >> 2] * DM + (tid & 3) * 8;
            LdF32<2> bl; bl.kstep = (size_t)32 * 256;
#pragma unroll
            for (int i = 0; i < 2; ++i) {
                const int q = tid + 512 * i, bk = q >> 5, bn = q & 31;
                const int wnn = bn >> 3, half = (bn >> 2) & 1, j8 = bn & 3;
                bl.p[i] = (half ? wu : wg) + (size_t)bk * 256 + c * 128 + wnn * 32 + j8 * 8;
            }
            f32x16 acc[2][2];
#pragma unroll
            for (int i = 0; i < 2; ++i)
#pragma unroll
                for (int j = 0; j < 2; ++j) acc[i][j] = f32x16{};
            gemm_core<128, 256, 2, 4, false>(acc, al, bl, DM / 32, L, L, 0);
#pragma unroll
            for (int mt = 0; mt < 2; ++mt)
#pragma unroll
                for (int r = 0; r < 16; ++r) {
                    const int row = wm * 64 + mt * 32 + crow(r, h);
                    const float gv = acc[mt][0][r], uv = acc[mt][1][r];
                    const float hv = gv / (1.f + __expf(-gv)) * uv * rwt[row];
                    *(LAS u16*)(Hl + row * HST + (c * 128 + wn * 32 + r32) * 2) = f2bf(hv);
                }
        }
        __syncthreads();
#pragma unroll 1
        for (int nc = 0; nc < 4; ++nc) {
            LdBf16<1> al; al.kstep = 0; al.p[0] = x1h;
            LdF32<2> bl; bl.kstep = (size_t)32 * 1024;
#pragma unroll
            for (int i = 0; i < 2; ++i) { const int q = tid + 512 * i; bl.p[i] = wd + (size_t)(q >> 5) * 1024 + nc * 256 + (q & 31) * 8; }
            f32x16 acc[2][2];
#pragma unroll
            for (int i = 0; i < 2; ++i)
#pragma unroll
                for (int j = 0; j < 2; ++j) acc[i][j] = f32x16{};
            gemm_core<128, 256, 2, 4, true>(acc, al, bl, 256 / 32, L, Hl, HST);
#pragma unroll
            for (int mt = 0; mt < 2; ++mt)
#pragma unroll
                for (int r = 0; r < 16; ++r) {
                    const int row = wm * 64 + mt * 32 + crow(r, h);
                    const int sr = rsrc[row];
                    if (sr >= 0) {
                        const int tk = sr >> 4, slot = sr & 15;
                        u16* dst = slot < 7 ? (u16*)(A.ws + WS_Y + (size_t)slot * 128 * MiB) + (size_t)tk * DM
                                            : (u16*)((unsigned char*)A.out + (size_t)tk * 4096 + (slot - 7) * 2048);
#pragma unroll
                        for (int nt = 0; nt < 2; ++nt) dst[nc * 256 + wn * 64 + nt * 32 + r32] = f2bf(acc[mt][nt][r]);
                    }
                }
        }
        __syncthreads();
    }
}

__device__ __forceinline__ void p7_final(const Args& A, int bid, int G) {
    const int tid = threadIdx.x, lane = tid & 63, wid = tid >> 6;
    const u16* x1h = (const u16*)(A.ws + WS_X1H);
    const float* gam = A.in[22]; const float* bet = A.in[23];
    for (int row = bid * 8 + wid; row < T_TOK; row += G * 8) {
        float v[16];
        {
            const bf16x8 a = *(const bf16x8*)(x1h + (size_t)row * DM + lane * 8), b = *(const bf16x8*)(x1h + (size_t)row * DM + 512 + lane * 8);
#pragma unroll
            for (int e = 0; e < 8; ++e) { v[e] = ALPHA * bf2f((u16)a[e]); v[8 + e] = ALPHA * bf2f((u16)b[e]); }
        }
#pragma unroll
        for (int s = 0; s < 9; ++s) {
            const u16* src = s < 7 ? (const u16*)(A.ws + WS_Y + (size_t)s * 128 * MiB) + (size_t)row * DM
                                   : (const u16*)((const unsigned char*)A.out + (size_t)row * 4096 + (s - 7) * 2048);
            const bf16x8 a = *(const bf16x8*)(src + lane * 8), b = *(const bf16x8*)(src + 512 + lane * 8);
#pragma unroll
            for (int e = 0; e < 8; ++e) { v[e] += bf2f((u16)a[e]); v[8 + e] += bf2f((u16)b[e]); }
        }
        float s = 0.f;
#pragma unroll
        for (int e = 0; e < 16; ++e) s += v[e];
        const float mean = wave_sum(s) * (1.f / 1024.f);
        float q = 0.f;
#pragma unroll
        for (int e = 0; e < 16; ++e) { v[e] -= mean; q += v[e] * v[e]; }
        const float rstd = rsqrtf(wave_sum(q) * (1.f / 1024.f) + LN_EPS);
        float* o = A.out + (size_t)row * DM;
#pragma unroll
        for (int hh = 0; hh < 2; ++hh)
#pragma unroll
            for (int q4i = 0; q4i < 2; ++q4i) {
                const int c = hh * 512 + lane * 8 + q4i * 4;
                const f32x4 gg = *(const f32x4*)(gam + c), bb = *(const f32x4*)(bet + c);
                f32x4 r; r.x = v[hh * 8 + q4i * 4] * rstd * gg.x + bb.x; r.y = v[hh * 8 + q4i * 4 + 1] * rstd * gg.y + bb.y; r.z = v[hh * 8 + q4i * 4 + 2] * rstd * gg.z + bb.z; r.w = v[hh * 8 + q4i * 4 + 3] * rstd * gg.w + bb.w;
                *(f32x4*)(o + c) = r;
            }
    }
}

__global__ void __launch_bounds__(512, 2) fwd_kernel(Args A) {
    extern __shared__ __attribute__((aligned(16))) unsigned char lds_raw[];
    ldsp L = (ldsp)lds_raw;
    const int tid = threadIdx.x, G = gridDim.x, bid = blockIdx.x;
    const int vcu = (G % 8 == 0) ? (bid % 8) * (G / 8) + bid / 8 : bid;
    volatile LAS unsigned* barw = (volatile LAS unsigned*)(L + LDS_BARW);
    if (tid < 4) barw[tid] = 0u;
    __syncthreads();
    XcdBarrier bar; bar.bar = (unsigned*)(A.ws + WS_BAR); bar.x = 0; bar.st = barw;
    if (N_LAUNCHES == 1) bar = xcd_barrier_post((unsigned*)(A.ws + WS_BAR), barw);
    const int lo = A.ph_lo, hi = A.ph_hi;
#define IN(k) (lo <= (k) && (k) < hi)
#define SEAM(k) do { if (IN(k) && IN((k) + 1)) xcd_barrier(bar); } while (0)

    if (IN(0)) { p0_prologue(A, L); }
    SEAM(0);
    if (IN(1)) { p1_proj(A, L, vcu, G); }
    SEAM(1);
    if (IN(2)) { p2_compress(A, L, bid, G); }
    SEAM(2);
    if (IN(3)) {
        for (int i = 0; i * G + vcu < 2048; ++i) {
            const int u = i * G + vcu; const int bg = u >> 5, qr = u & 31;
            const int qt = (i & 1) ? 31 - qr : qr;
            int z = 0; asm volatile("" : "+v"(z));
            p3_unit(A, L, bg >> 1, bg & 1, qt, z);
            __syncthreads();
        }
    }
    SEAM(3);
    if (IN(4)) { for (int p = vcu; p < T_TOK / 128; p += G) p4_unit(A, L, p); }
    SEAM(4);
    if (IN(5)) { p5_fill(A, L, bid, G); }
    SEAM(5);
    if (IN(6)) { p6_moe(A, L, vcu, G); }
    SEAM(6);
    if (IN(7)) { p7_final(A, bid, G); }
#undef IN
#undef SEAM
}

extern "C" void kernel_launch(void* const* d_in, const int* in_sizes, int n_in, void* d_out, int out_size, void* d_ws, size_t ws_size, hipStream_t stream) {
    static int grid = 0;
    if (grid == 0) {
        if (n_in != 24 || out_size != T_TOK * DM || ws_size < WS_END) { fprintf(stderr, "kernel_launch: unexpected problem (n_in %d out %d ws %zu)\n", n_in, out_size, ws_size); grid = -1; return; }
        int dev = 0, cus = 0;
        if (hipGetDevice(&dev) != hipSuccess || hipDeviceGetAttribute(&cus, hipDeviceAttributeMultiprocessorCount, dev) != hipSuccess) { grid = -1; return; }
        if (hipFuncSetAttribute((const void*)fwd_kernel, hipFuncAttributeMaxDynamicSharedMemorySize, LDS_BYTES) != hipSuccess) { fprintf(stderr, "kernel_launch: hipFuncSetAttribute failed\n"); grid = -1; return; }
        int per_cu = 0;
        if (hipOccupancyMaxActiveBlocksPerMultiprocessor(&per_cu, (const void*)fwd_kernel, 512, LDS_BYTES) != hipSuccess || per_cu < 1) { fprintf(stderr, "kernel_launch: occupancy query says %d\n", per_cu); }
        (void)hipGetLastError();
        grid = cus;
    }
    if (grid < 0) return;
    (void)hipMemsetAsync(d_ws, 0, WS_ZERO_BYTES, stream);
    Args a{};
    for (int i = 0; i < 24; ++i) a.in[i] = (const float*)d_in[i];
    a.out = (float*)d_out; a.ws = (unsigned char*)d_ws;
    if (N_LAUNCHES == 1) {
        a.ph_lo = 0; a.ph_hi = 8;
        hipLaunchKernelGGL(fwd_kernel, dim3(grid), dim3(512), LDS_BYTES, stream, a);
    } else {
        for (int p = 0; p < 8; ++p) { a.ph_lo = p; a.ph_hi = p + 1; hipLaunchKernelGGL(fwd_kernel, dim3(grid), dim3(512), LDS_BYTES, stream, a); }
    }
}
```

```cpp
#include <hip/hip_runtime.h>
#include <stdint.h>
#include <stdio.h>

#ifndef N_LAUNCHES
#define N_LAUNCHES 1
#endif

#define LAS __attribute__((address_space(3)))
typedef unsigned short u16;
typedef short bf16x8 __attribute__((ext_vector_type(8)));
typedef short s16x4 __attribute__((ext_vector_type(4)));
typedef short v4i16_t __attribute__((ext_vector_type(4)));
typedef float f32x16 __attribute__((ext_vector_type(16)));
typedef float f32x4 __attribute__((ext_vector_type(4)));
typedef unsigned u32x4 __attribute__((ext_vector_type(4)));
typedef unsigned u32x2 __attribute__((ext_vector_type(2)));
typedef float f32x2_t __attribute__((ext_vector_type(2)));
typedef __bf16 bf16x2_t __attribute__((ext_vector_type(2)));
typedef LAS char* ldsp;

constexpr int T_TOK = 65536, DM = 1024, SEQ = 2048;
constexpr int NPROJ = 2840, NPAD = 2944;
constexpr int C_B = 0, C_C = 512, C_U = 1024, C_Q = 1536, C_KC = 2048, C_VC = 2176, C_KS = 2304, C_VS = 2432, C_KW = 2560, C_VW = 2688, C_GL = 2816;
constexpr float ALPHA = 1.189207115002721f;
constexpr float LOG2E = 1.4426950408889634f;
constexpr float LN_EPS = 1e-5f;
constexpr int NEXP = 256;

constexpr size_t MiB = 1ull << 20;
constexpr size_t WS_BAR = 0;
constexpr size_t WS_CNT = 16384;
constexpr size_t WS_ZERO_BYTES = 32768;
constexpr size_t WS_TOKE = 1 * MiB;
constexpr size_t WS_TOKW = 3 * MiB;
constexpr size_t WS_TOKP = 5 * MiB;
constexpr size_t WS_SSRC = 7 * MiB;
constexpr size_t WS_SW   = 9 * MiB;
constexpr size_t WS_X1H  = 12 * MiB;
constexpr size_t WS_Y    = 140 * MiB;
constexpr size_t WS_END  = WS_Y + 7 * 128 * MiB;
constexpr size_t WS_XB   = 140 * MiB;
constexpr size_t WS_PROJ = 268 * MiB;
constexpr size_t WS_MIX  = 636 * MiB;
constexpr size_t WS_WIN  = 764 * MiB;
constexpr size_t WS_WOUT = 770 * MiB;
constexpr size_t WS_RWH  = 772 * MiB;
constexpr size_t WS_RWL  = 772 * MiB + 512 * 1024;
constexpr size_t WS_CW1  = 773 * MiB;
constexpr size_t WS_CB   = 773 * MiB + 512 * 1024;
constexpr size_t WS_KCMP = 774 * MiB;
constexpr size_t WS_VCMP = 775 * MiB;

constexpr int LDS_BYTES = 147456;
constexpr int LDS_BARW = LDS_BYTES - 16;

__device__ __forceinline__ unsigned cvtpk(float lo, float hi) { f32x2_t v = {lo, hi}; bf16x2_t b = __builtin_convertvector(v, bf16x2_t); return __builtin_bit_cast(unsigned, b); }
__device__ __forceinline__ u16 f2bf(float f) { return (u16)(cvtpk(f, 0.f) & 0xffffu); }
__device__ __forceinline__ float bf2f(u16 b) { return __uint_as_float(((unsigned)b) << 16); }
__device__ __forceinline__ bf16x8 lds_rd128(ldsp p) { return *(LAS bf16x8*)p; }
__device__ __forceinline__ void lds_wr128(ldsp p, bf16x8 v) { *(LAS bf16x8*)p = v; }
__device__ __forceinline__ s16x4 lds_tr(ldsp p) { return __builtin_bit_cast(s16x4, __builtin_amdgcn_ds_read_tr16_b64_v4i16((LAS v4i16_t*)p)); }
__device__ __forceinline__ bf16x8 tr_pair(ldsp p0, ldsp p1) { s16x4 lo = lds_tr(p0), hi = lds_tr(p1); return (bf16x8){lo[0], lo[1], lo[2], lo[3], hi[0], hi[1], hi[2], hi[3]}; }
__device__ __forceinline__ float swap32(float v) { return __shfl_xor(v, 32); }
__device__ __forceinline__ float wave_sum(float v) {
#pragma unroll
    for (int o = 32; o >= 1; o >>= 1) v += __shfl_xor(v, o);
    return v;
}
__device__ __forceinline__ int crow(int r, int h) { return (r & 3) + 8 * (r >> 2) + 4 * h; }
#define VM_WAIT() asm volatile("s_waitcnt vmcnt(0)" ::: "memory")

struct RawF32 { f32x4 a, b; };
__device__ __forceinline__ bf16x8 cvt8(const RawF32& r) {
    u32x4 w; w.x = cvtpk(r.a.x, r.a.y); w.y = cvtpk(r.a.z, r.a.w); w.z = cvtpk(r.b.x, r.b.y); w.w = cvtpk(r.b.z, r.b.w);
    return __builtin_bit_cast(bf16x8, w);
}

template <int N> struct LdBf16 {
    const u16* p[N]; size_t kstep; typedef bf16x8 Raw;
    __device__ __forceinline__ Raw load(int i, int kt) const { return *(const bf16x8*)(p[i] + (size_t)kt * kstep); }
    __device__ __forceinline__ bf16x8 cvt(const Raw& r) const { return r; }
};
template <int N> struct LdF32 {
    const float* p[N]; size_t kstep; typedef RawF32 Raw;
    __device__ __forceinline__ Raw load(int i, int kt) const { const f32x4* q = (const f32x4*)(p[i] + (size_t)kt * kstep); RawF32 r; r.a = q[0]; r.b = q[1]; return r; }
    __device__ __forceinline__ bf16x8 cvt(const Raw& r) const { return cvt8(r); }
};
struct LdCmpA {
    const u16* p; typedef bf16x8 Raw;
    __device__ __forceinline__ Raw load(int, int kt) const { return *(const bf16x8*)(p + (size_t)(kt >> 1) * NPAD + (kt & 1) * 32); }
    __device__ __forceinline__ bf16x8 cvt(const Raw& r) const { return r; }
};
struct LdSplitA {
    const float* p; int mode; typedef RawF32 Raw;
    __device__ __forceinline__ Raw load(int, int kt) const { const f32x4* q = (const f32x4*)(p + kt * 32); RawF32 r; r.a = q[0]; r.b = q[1]; return r; }
    __device__ __forceinline__ bf16x8 cvt(const Raw& r) const {
        if (mode == 0) return cvt8(r);
        RawF32 d;
#pragma unroll
        for (int i = 0; i < 4; ++i) { d.a[i] = r.a[i] - bf2f(f2bf(r.a[i])); d.b[i] = r.b[i] - bf2f(f2bf(r.b[i])); }
        return cvt8(d);
    }
};

template <int BM, int BN, int WM, int WN, bool A_RES, class AL, class BL>
__device__ __forceinline__ void gemm_core(f32x16 (&acc)[BM / (WM * 32)][BN / (WN * 32)], const AL& al, const BL& bl, const int nk, ldsp st, ldsp ares, const int ares_stride) {
    constexpr int MT = BM / (WM * 32), NT = BN / (WN * 32);
    constexpr int NA = A_RES ? 0 : (BM * 4) / 512;
    constexpr int BCH = 32 * (BN / 8);
    constexpr int NBC = (BCH + 511) / 512;
    constexpr int AST = 80, BST = BN * 2 + 64;
    constexpr int ABYTES = A_RES ? 0 : BM * AST, BBYTES = 32 * BST, STAGE = ABYTES + BBYTES;
    static_assert(WM * WN == 8 && (A_RES || BM >= 128), "geometry");
    const int tid = threadIdx.x, lane = tid & 63, wid = tid >> 6;
    const int wm = wid / WN, wn = wid % WN, h = lane >> 5, r32 = lane & 31;
    const int q4 = (lane & 15) >> 2, p4 = lane & 3, g1 = (lane >> 4) & 1;
    const bool bact = (BCH >= 512) || (tid < BCH);
    int adst[NA > 0 ? NA : 1], bdst[NBC];
#pragma unroll
    for (int i = 0; i < NA; ++i) adst[i] = ((tid >> 2) + 128 * i) * AST + (tid & 3) * 16;
#pragma unroll
    for (int i = 0; i < NBC; ++i) { const int q = tid + 512 * i; bdst[i] = ABYTES + (q / (BN / 8)) * BST + (q % (BN / 8)) * 16; }
    const int afrag0 = A_RES ? ((wm * MT * 32 + r32) * ares_stride + h * 16) : ((wm * MT * 32 + r32) * AST + h * 16);
    const int bfrag0 = ABYTES + (8 * h + q4) * BST + (wn * NT * 32 + 16 * g1 + 4 * p4) * 2;
    typename AL::Raw ra[NA > 0 ? NA : 1]; typename BL::Raw rb[NBC];
#pragma unroll
    for (int i = 0; i < NA; ++i) ra[i] = al.load(i, 0);
    if (bact) {
#pragma unroll
        for (int i = 0; i < NBC; ++i) rb[i] = bl.load(i, 0);
    }
#pragma unroll
    for (int i = 0; i < NA; ++i) lds_wr128(st + adst[i], al.cvt(ra[i]));
    if (bact) {
#pragma unroll
        for (int i = 0; i < NBC; ++i) lds_wr128(st + bdst[i], bl.cvt(rb[i]));
    }
    __syncthreads();
    for (int kt = 0; kt < nk; ++kt) {
        ldsp cur = st + (kt & 1) * STAGE, nxt = st + ((kt & 1) ^ 1) * STAGE;
        const bool more = kt + 1 < nk;
        if (more) {
#pragma unroll
            for (int i = 0; i < NA; ++i) ra[i] = al.load(i, kt + 1);
            if (bact) {
#pragma unroll
                for (int i = 0; i < NBC; ++i) rb[i] = bl.load(i, kt + 1);
            }
        }
#pragma unroll
        for (int s = 0; s < 2; ++s) {
            bf16x8 af[MT], bfr[NT];
#pragma unroll
            for (int mt = 0; mt < MT; ++mt)
                af[mt] = A_RES ? lds_rd128(ares + afrag0 + mt * 32 * ares_stride + kt * 64 + s * 32) : lds_rd128(cur + afrag0 + mt * 32 * AST + s * 32);
#pragma unroll
            for (int nt = 0; nt < NT; ++nt)
                bfr[nt] = tr_pair(cur + bfrag0 + (16 * s) * BST + nt * 64, cur + bfrag0 + (16 * s + 4) * BST + nt * 64);
#pragma unroll
            for (int mt = 0; mt < MT; ++mt)
#pragma unroll
                for (int nt = 0; nt < NT; ++nt) acc[mt][nt] = __builtin_amdgcn_mfma_f32_32x32x16_bf16(af[mt], bfr[nt], acc[mt][nt], 0, 0, 0);
        }
        if (more) {
#pragma unroll
            for (int i = 0; i < NA; ++i) lds_wr128(nxt + adst[i], al.cvt(ra[i]));
            if (bact) {
#pragma unroll
                for (int i = 0; i < NBC; ++i) lds_wr128(nxt + bdst[i], bl.cvt(rb[i]));
            }
        }
        __syncthreads();
    }
}

#define XB_TMO      128
#define XB_XCNT(j)  (256  + 64 * (j))
#define XB_XSUB(j)  (1280 + 64 * (j))
#define XB_XGEN(j)  (2304 + 64 * (j))
#define XB_TOP      3328
#define XB_TOPGEN   3392
#define XCD_BAR_WORDS 3456
#define XB_SPIN_CAP (1u << 22)
__device__ __forceinline__ unsigned xb_ld(unsigned* p)              { return __hip_atomic_load(p, __ATOMIC_RELAXED, __HIP_MEMORY_SCOPE_AGENT); }
__device__ __forceinline__ unsigned xb_add(unsigned* p, unsigned v) { return __hip_atomic_fetch_add(p, v, __ATOMIC_RELAXED, __HIP_MEMORY_SCOPE_AGENT); }
__device__ __forceinline__ unsigned xb_xcc_id() { return (unsigned)__builtin_amdgcn_s_getreg((3 << 11) | 20) & 0xFu; }
#define XB_SPIN(cond, bar) do { unsigned _sp = 0; while (cond) { __builtin_amdgcn_s_sleep(1); \
    if ((++_sp & 255u) == 0u) { if (xb_ld(&(bar)[XB_TMO])) break; if (_sp > XB_SPIN_CAP) { atomicAdd(&(bar)[XB_TMO], 1u); break; } } } } while (0)
struct XcdBarrier { unsigned* bar; unsigned x; volatile LAS unsigned* st; };
__device__ __forceinline__ XcdBarrier xcd_barrier_post(unsigned* bar, volatile LAS unsigned* st) {
    XcdBarrier b; b.bar = bar; b.x = xb_xcc_id(); b.st = st;
    if (threadIdx.x == 0) (void)xb_add(&bar[XB_XCNT(b.x)], 1u);
    return b;
}
__device__ __forceinline__ void xcd_barrier_complete(unsigned* bar, unsigned x, unsigned& nloc, unsigned& nx) {
    const unsigned G = gridDim.x * gridDim.y * gridDim.z;
    unsigned sum, cnt, mine, sp = 0u;
    for (;;) {
        sum = 0u; cnt = 0u; mine = 0u;
#pragma unroll
        for (unsigned j = 0; j < 16; ++j) { const unsigned c = xb_ld(&bar[XB_XCNT(j)]); sum += c; cnt += (c > 0u) ? 1u : 0u; mine = (j == x) ? c : mine; }
        if (sum == G) break;
        __builtin_amdgcn_s_sleep(1);
        if ((++sp & 255u) == 0u) { if (xb_ld(&bar[XB_TMO])) break; if (sp > XB_SPIN_CAP) { atomicAdd(&bar[XB_TMO], 1u); break; } }
    }
    nloc = mine > 0u ? mine : 1u; nx = cnt > 0u ? cnt : 1u;
}
__device__ __forceinline__ void xcd_barrier(const XcdBarrier& b) {
    asm volatile("s_waitcnt vmcnt(0)" ::: "memory");
    __syncthreads();
    if (threadIdx.x == 0) {
        unsigned* bar = b.bar;
        __builtin_amdgcn_s_waitcnt(0);
        unsigned nloc = b.st[0], nx = b.st[1];
        if (nloc == 0u) { xcd_barrier_complete(bar, b.x, nloc, nx); b.st[0] = nloc; b.st[1] = nx; }
        const unsigned old = xb_add(&bar[XB_XSUB(b.x)], 1u);
        const unsigned gen = old / nloc;
        if (old + 1u == (gen + 1u) * nloc) {
            __builtin_amdgcn_fence(__ATOMIC_RELEASE, "agent");
            asm volatile("s_waitcnt vmcnt(0)" ::: "memory");
            const unsigned og = xb_add(&bar[XB_TOP], 1u);
            const unsigned tg = og / nx;
            if (og + 1u == (tg + 1u) * nx) xb_add(&bar[XB_TOPGEN], 1u);
            else XB_SPIN(xb_ld(&bar[XB_TOPGEN]) == tg, bar);
            __builtin_amdgcn_fence(__ATOMIC_ACQUIRE, "agent");
            xb_add(&bar[XB_XGEN(b.x)], 1u);
            asm volatile("s_waitcnt vmcnt(0)" ::: "memory");
        } else {
            XB_SPIN(xb_ld(&bar[XB_XGEN(b.x)]) == gen, bar);
            __builtin_amdgcn_fence(__ATOMIC_ACQUIRE, "agent");
            asm volatile("s_waitcnt vmcnt(0)" ::: "memory");
        }
    }
    __syncthreads();
}

struct Args {
    const float* in[24];
    float* out;
    unsigned char* ws;
    int ph_lo, ph_hi;
};

__device__ __forceinline__ void p0_prologue(const Args& A, ldsp L) {
    const int tid = threadIdx.x, G = gridDim.x, bid = blockIdx.x;
    const size_t gt = (size_t)bid * 512 + tid, gs = (size_t)G * 512;
    unsigned char* ws = A.ws;
    {
        const f32x4* src = (const f32x4*)A.in[0]; u32x4* dst = (u32x4*)(ws + WS_XB);
        const size_t n8 = (size_t)T_TOK * DM / 8;
        for (size_t i = gt; i < n8; i += gs) { const f32x4 a = src[2 * i], b = src[2 * i + 1]; u32x4 w; w.x = cvtpk(a.x, a.y); w.y = cvtpk(a.z, a.w); w.z = cvtpk(b.x, b.y); w.w = cvtpk(b.z, b.w); dst[i] = w; }
    }
    {
        const float* w = A.in[1]; u32x4* dst = (u32x4*)(ws + WS_WIN);
        const size_t n8 = (size_t)1024 * (NPAD / 8);
        for (size_t i = gt; i < n8; i += gs) {
            const int k = (int)(i / (NPAD / 8)), c8 = (int)(i % (NPAD / 8));
            u32x4 o = {0u, 0u, 0u, 0u};
            if (c8 * 8 < NPROJ) { const float* s = w + (size_t)k * NPROJ + c8 * 8; o.x = cvtpk(s[0], s[1]); o.y = cvtpk(s[2], s[3]); o.z = cvtpk(s[4], s[5]); o.w = cvtpk(s[6], s[7]); }
            dst[i] = o;
        }
    }
    {
        const f32x4* src = (const f32x4*)A.in[11]; u32x4* dst = (u32x4*)(ws + WS_WOUT);
        const size_t n8 = (size_t)1024 * 1024 / 8;
        for (size_t i = gt; i < n8; i += gs) { const f32x4 a = src[2 * i], b = src[2 * i + 1]; u32x4 w; w.x = cvtpk(a.x, a.y); w.y = cvtpk(a.z, a.w); w.z = cvtpk(b.x, b.y); w.w = cvtpk(b.z, b.w); dst[i] = w; }
    }
    {
        const float* src = A.in[14]; u16* dh = (u16*)(ws + WS_RWH); u16* dl = (u16*)(ws + WS_RWL);
        for (size_t i = gt; i < (size_t)1024 * 256; i += gs) { const float v = src[i]; const u16 hb = f2bf(v); dh[i] = hb; dl[i] = f2bf(v - bf2f(hb)); }
    }
    {
        u16* d = (u16*)(ws + WS_CW1);
        for (size_t i = gt; i < (size_t)2 * 2048 * 64; i += gs) { const int kv = (int)(i >> 17); const size_t r = i & 131071; d[i] = f2bf((kv ? A.in[8] : A.in[4])[r]); }
    }
    {
        u16* kc = (u16*)(ws + WS_KCMP); u16* vc = (u16*)(ws + WS_VCMP);
        for (size_t i = gt; i < (size_t)32 * 128; i += gs) { const int b = (int)(i >> 7), r = (int)(i & 127); kc[((size_t)(b * 128 + 127) * 2) * 64 + r] = 0; vc[((size_t)(b * 128 + 127) * 2) * 64 + r] = 0; }
    }
    if (bid == 0) {
        LAS float* part = (LAS float*)L;
        const int o = tid & 127, prt = tid >> 7, kv = o >> 6, n = o & 63;
        const float* pos = kv ? A.in[7] : A.in[3]; const float* w1 = kv ? A.in[8] : A.in[4];
        float s = 0.f;
        for (int kk = prt * 512; kk < prt * 512 + 512; ++kk) s += pos[kk] * w1[(size_t)kk * 64 + n];
        part[prt * 128 + o] = s;
        __syncthreads();
        if (tid < 128) { const float* b1 = kv ? A.in[9] : A.in[5]; ((float*)(ws + WS_CB))[tid] = part[tid] + part[128 + tid] + part[256 + tid] + part[384 + tid] + b1[n]; }
        __syncthreads();
    }
}

__device__ __forceinline__ void p1_proj(const Args& A, ldsp L, int vcu, int G) {
    const int tid = threadIdx.x, lane = tid & 63, wid = tid >> 6, h = lane >> 5, r32 = lane & 31;
    const u16* xb = (const u16*)(A.ws + WS_XB); const u16* wp = (const u16*)(A.ws + WS_WIN); u16* proj = (u16*)(A.ws + WS_PROJ);
    constexpr int NTN = NPAD / 128;
    const int wm = wid >> 1, wn = wid & 1;
    for (int u = vcu; u < (T_TOK / 256) * NTN; u += G) {
        const int pm = u / NTN, pn = u % NTN, m0 = pm * 256, n0 = pn * 128;
        LdBf16<2> al; al.kstep = 32;
        al.p[0] = xb + (size_t)(m0 + (tid >> 2)) * DM + (tid & 3) * 8; al.p[1] = al.p[0] + (size_t)128 * DM;
        LdBf16<1> bl; bl.kstep = (size_t)32 * NPAD;
        bl.p[0] = wp + (size_t)(tid >> 4) * NPAD + n0 + (tid & 15) * 8;
        f32x16 acc[2][2];
#pragma unroll
        for (int i = 0; i < 2; ++i)
#pragma unroll
            for (int j = 0; j < 2; ++j) acc[i][j] = f32x16{};
        gemm_core<256, 128, 4, 2, false>(acc, al, bl, DM / 32, L, L, 0);
#pragma unroll
        for (int mt = 0; mt < 2; ++mt)
#pragma unroll
            for (int nt = 0; nt < 2; ++nt)
#pragma unroll
                for (int r = 0; r < 16; ++r) {
                    const int row = m0 + wm * 64 + mt * 32 + crow(r, h), col = n0 + wn * 64 + nt * 32 + r32;
                    proj[(size_t)row * NPAD + col] = f2bf(acc[mt][nt][r]);
                }
    }
}

__device__ __forceinline__ float gelu_tanh(float x) { const float u = 0.7978845608028654f * (x + 0.044715f * x * x * x); return 0.5f * x * (1.f + tanhf(u)); }
__device__ __forceinline__ void p2_compress(const Args& A, ldsp L, int bid, int G) {
    const int tid = threadIdx.x, lane = tid & 63, wid = tid >> 6, h = lane >> 5, r32 = lane & 31;
    const u16* proj = (const u16*)(A.ws + WS_PROJ);
    const int wm = wid >> 1, wn = wid & 1;
    for (int u = bid; u < 128; u += G) {
        const int kv = u >> 6, r0 = (u & 63) * 128;
        int rr = r0 + (tid >> 2); if (rr > 8127) rr = 8127;
        const int b = rr / 254, rem = rr % 254, ci = rem >> 1, g = rem & 1;
        LdCmpA al; al.p = proj + (size_t)(b * SEQ + 16 * ci) * NPAD + (kv ? C_VC : C_KC) + g * 64 + (tid & 3) * 8;
        LdBf16<1> bl; bl.kstep = 32 * 64;
        bl.p[0] = (const u16*)(A.ws + WS_CW1) + (size_t)kv * 2048 * 64 + (size_t)((tid & 255) >> 3) * 64 + (tid & 7) * 8;
        f32x16 acc[1][1]; acc[0][0] = f32x16{};
        gemm_core<128, 64, 4, 2, false>(acc, al, bl, 2048 / 32, L, L, 0);
        LAS float* hid = (LAS float*)(L + 32768);
        const float* cb = (const float*)(A.ws + WS_CB) + kv * 64;
#pragma unroll
        for (int r = 0; r < 16; ++r) { const int row = wm * 32 + crow(r, h), col = wn * 32 + r32; hid[row * 65 + col] = gelu_tanh(acc[0][0][r] + cb[col]); }
        __syncthreads();
        {
            const int row = tid >> 2, qd = tid & 3;
            const float* w2 = kv ? A.in[10] : A.in[6];
            float o[16];
#pragma unroll
            for (int j = 0; j < 16; ++j) o[j] = 0.f;
            for (int n = 0; n < 64; ++n) { const float hv = hid[row * 65 + n]; const float* wr = w2 + n * 64 + qd * 16;
#pragma unroll
                for (int j = 0; j < 16; ++j) o[j] += hv * wr[j]; }
            const int r2 = r0 + row;
            if (r2 < 8128) {
                const int b2 = r2 / 254, rem2 = r2 % 254, ci2 = rem2 >> 1, g2 = rem2 & 1;
                u16* dst = (u16*)(A.ws + (kv ? WS_VCMP : WS_KCMP)) + ((size_t)(b2 * 128 + ci2) * 2 + g2) * 64 + qd * 16;
                u32x4 w0, w1;
                w0.x = cvtpk(o[0], o[1]); w0.y = cvtpk(o[2], o[3]); w0.z = cvtpk(o[4], o[5]); w0.w = cvtpk(o[6], o[7]);
                w1.x = cvtpk(o[8], o[9]); w1.y = cvtpk(o[10], o[11]); w1.z = cvtpk(o[12], o[13]); w1.w = cvtpk(o[14], o[15]);
                *(u32x4*)dst = w0; *(u32x4*)(dst + 8) = w1;
            }
        }
        __syncthreads();
    }
}

constexpr int L3_KC = 0, L3_VC = 18432, L3_BUF = 0, L3_BUFSZ = 21504, L3_E = 43008, L3_F = 75776, L3_IMP = 108544, L3_SEL = 116736, L3_UNI = 116992, L3_JOBS = 117008, L3_NJOB = 117264;
constexpr float NEGBIG = -1e30f;

__device__ __forceinline__ void p3_unit(const Args& A, ldsp L, const int b, const int g, const int qt, const int zlaunder) {
    const int tid = threadIdx.x + zlaunder, lane = tid & 63, wid = tid >> 6, h = lane >> 5, r32 = lane & 31;
    const int q4 = (lane & 15) >> 2, p4 = lane & 3, g1 = (lane >> 4) & 1;
    const u16* proj = (const u16*)(A.ws + WS_PROJ);
    u16* mix = (u16*)(A.ws + WS_MIX);
    const int r = wid >> 1, qh = wid & 1, head = g * 4 + r;
    const int ql = qh * 32 + r32, tq = qt * 64 + ql;
    const size_t trow = (size_t)b * SEQ + tq;
    const float slope2 = exp2f(-(float)(head + 1)) * LOG2E, sc2 = 0.125f * LOG2E;
    LAS unsigned* selm = (LAS unsigned*)(L + L3_SEL);
    LAS unsigned* uni = (LAS unsigned*)(L + L3_UNI);
    LAS int* jobs = (LAS int*)(L + L3_JOBS);
    LAS int* njobp = (LAS int*)(L + L3_NJOB);
    if (tid == 0) uni[0] = 0u;
    bf16x8 qf[4];
#pragma unroll
    for (int s = 0; s < 4; ++s) qf[s] = *(const bf16x8*)(proj + trow * NPAD + C_Q + head * 64 + 16 * s + 8 * h);
    float gate[3];
#pragma unroll
    for (int i = 0; i < 3; ++i) { const float x = bf2f(proj[trow * NPAD + C_GL + head * 3 + i]); gate[i] = 1.f / (1.f + __expf(-x)); }
    {
        const u16* kc = (const u16*)(A.ws + WS_KCMP); const u16* vc = (const u16*)(A.ws + WS_VCMP);
#pragma unroll
        for (int i = 0; i < 2; ++i) {
            const int c = tid + 512 * i, n = c >> 3, ch = c & 7;
            const size_t so = ((size_t)(b * 128 + n) * 2 + g) * 64 + ch * 8;
            lds_wr128(L + L3_KC + n * 144 + ch * 16, *(const bf16x8*)(kc + so));
            lds_wr128(L + L3_VC + n * 192 + ch * 16, *(const bf16x8*)(vc + so));
        }
    }
    __syncthreads();
    f32x16 otot[2]; otot[0] = f32x16{}; otot[1] = f32x16{};
    {
        f32x16 sc[4];
        float m = NEGBIG;
#pragma unroll
        for (int kt = 0; kt < 4; ++kt) {
            sc[kt] = f32x16{};
#pragma unroll
            for (int s = 0; s < 4; ++s) sc[kt] = __builtin_amdgcn_mfma_f32_32x32x16_bf16(lds_rd128(L + L3_KC + (kt * 32 + r32) * 144 + (2 * s + h) * 16), qf[s], sc[kt], 0, 0, 0);
#pragma unroll
            for (int rg = 0; rg < 16; ++rg) {
                const int n = kt * 32 + crow(rg, h); const int dist = tq - (16 * n + 31);
                const bool valid = (dist >= 0) && (n < 127);
                const float v = sc[kt][rg] * sc2 - slope2 * (float)dist;
                sc[kt][rg] = valid ? v : NEGBIG;
                m = fmaxf(m, sc[kt][rg]);
            }
            __builtin_amdgcn_sched_barrier(0);
        }
        m = fmaxf(m, swap32(m));
        float l = 0.f;
#pragma unroll
        for (int kt = 0; kt < 4; ++kt)
#pragma unroll
            for (int rg = 0; rg < 16; ++rg) { const float p = (sc[kt][rg] > -1e29f) ? __builtin_amdgcn_exp2f(sc[kt][rg] - m) : 0.f; sc[kt][rg] = p; l += p; }
        l += swap32(l);
        const float inv = l > 0.f ? 1.f / l : 0.f;
        LAS float* E = (LAS float*)(L + L3_E) + (r * 64 + ql) * 32;
        LAS float* F = (LAS float*)(L + L3_F) + (r * 64 + ql) * 32;
        if (h == 0) F[0] = 0.f;
#pragma unroll
        for (int kt = 0; kt < 4; ++kt)
#pragma unroll
            for (int gq = 0; gq < 4; ++gq) {
                const float p0 = sc[kt][4 * gq] * inv, p1 = sc[kt][4 * gq + 1] * inv, p2 = sc[kt][4 * gq + 2] * inv, p3 = sc[kt][4 * gq + 3] * inv;
                sc[kt][4 * gq] = p0; sc[kt][4 * gq + 1] = p1; sc[kt][4 * gq + 2] = p2; sc[kt][4 * gq + 3] = p3;
                const int j = 8 * kt + 2 * gq + h;
                E[j] = (p0 + p1) + (p2 + p3);
                if (j + 1 < 32) F[j + 1] = p3;
            }
        f32x16 o[2]; o[0] = f32x16{}; o[1] = f32x16{};
#pragma unroll
        for (int ks = 0; ks < 8; ++ks) {
            const int kt = ks >> 1, sb = (ks & 1) * 8;
            u32x4 pw; pw.x = cvtpk(sc[kt][sb], sc[kt][sb + 1]); pw.y = cvtpk(sc[kt][sb + 2], sc[kt][sb + 3]); pw.z = cvtpk(sc[kt][sb + 4], sc[kt][sb + 5]); pw.w = cvtpk(sc[kt][sb + 6], sc[kt][sb + 7]);
            const bf16x8 pf = __builtin_bit_cast(bf16x8, pw);
#pragma unroll
            for (int dt = 0; dt < 2; ++dt) {
                ldsp vp = L + L3_VC + (16 * ks + 4 * h + q4) * 192 + (dt * 32 + 16 * g1 + 4 * p4) * 2;
                o[dt] = __builtin_amdgcn_mfma_f32_32x32x16_bf16(tr_pair(vp, vp + 8 * 192), pf, o[dt], 0, 0, 0);
            }
        }
#pragma unroll
        for (int dt = 0; dt < 2; ++dt)
#pragma unroll
            for (int rg = 0; rg < 16; ++rg) otot[dt][rg] = gate[0] * o[dt][rg];
    }
    __syncthreads();
    {
        const int qq = tid >> 3, sub = tid & 7;
        LAS float* impl = (LAS float*)(L + L3_IMP);
#pragma unroll
        for (int jj = 0; jj < 4; ++jj) {
            const int j = sub * 4 + jj; float s = 0.f;
#pragma unroll
            for (int rr = 0; rr < 4; ++rr) s += ((LAS float*)(L + L3_E))[(rr * 64 + qq) * 32 + j] + ((LAS float*)(L + L3_F))[(rr * 64 + qq) * 32 + j];
            impl[qq * 32 + j] = s;
        }
        __syncthreads();
        const int nfree = 8 - (qt == 0 ? 1 : 2);
        unsigned mk = 0u;
#pragma unroll
        for (int jj = 0; jj < 4; ++jj) {
            const int j = sub * 4 + jj;
            if (j == 0 || j == qt) mk |= 1u << j;
            else if (j < qt) {
                const float mine = impl[qq * 32 + j]; int rank = 0;
                for (int j2 = 1; j2 < qt; ++j2) { const float o2 = impl[qq * 32 + j2]; rank += (o2 > mine || (o2 == mine && j2 < j)) ? 1 : 0; }
                if (rank < nfree) mk |= 1u << j;
            }
        }
        mk |= __shfl_xor(mk, 1); mk |= __shfl_xor(mk, 2); mk |= __shfl_xor(mk, 4);
        if (sub == 0) { selm[qq] = mk; atomicOr((unsigned*)uni, mk); }
        __syncthreads();
        if (tid == 0) {
            const unsigned um = uni[0]; int n = 0;
            for (int j = 0; j <= qt; ++j) if ((um >> j) & 1u) jobs[n++] = (1 << 8) | j;
            for (int j = (qt >= 8 ? qt - 8 : 0); j <= qt; ++j) jobs[n++] = (2 << 8) | j;
            njobp[0] = n;
        }
        __syncthreads();
    }
    {
        const int njob = __builtin_amdgcn_readfirstlane(njobp[0]);
        const unsigned mysel = selm[ql];
        const int lrow = tid >> 3, lch = tid & 7;
        float m = NEGBIG, l = 0.f; f32x16 o[2]; o[0] = f32x16{}; o[1] = f32x16{};
        int curkind = 1;
        bf16x8 kreg, vreg;
        {
            const int jb = __builtin_amdgcn_readfirstlane(jobs[0]), kind = jb >> 8, j = jb & 255;
            const u16* src = proj + ((size_t)b * SEQ + 64 * j + lrow) * NPAD + g * 64 + lch * 8;
            kreg = *(const bf16x8*)(src + (kind == 1 ? C_KS : C_KW)); vreg = *(const bf16x8*)(src + (kind == 1 ? C_VS : C_VW));
        }
        lds_wr128(L + L3_BUF + lrow * 144 + lch * 16, kreg);
        lds_wr128(L + L3_BUF + 9216 + lrow * 192 + lch * 16, vreg);
        __syncthreads();
#pragma unroll 1
        for (int i = 0; i < njob; ++i) {
            const bool more = i + 1 < njob;
            if (more) {
                const int jb = __builtin_amdgcn_readfirstlane(jobs[i + 1]), kind = jb >> 8, j = jb & 255;
                const u16* src = proj + ((size_t)b * SEQ + 64 * j + lrow) * NPAD + g * 64 + lch * 8;
                kreg = *(const bf16x8*)(src + (kind == 1 ? C_KS : C_KW)); vreg = *(const bf16x8*)(src + (kind == 1 ? C_VS : C_VW));
            }
            const int jb = __builtin_amdgcn_readfirstlane(jobs[i]), kind = jb >> 8, j = jb & 255;
            if (kind != curkind) {
                const float f = gate[1] * (l > 0.f ? 1.f / l : 0.f);
#pragma unroll
                for (int dt = 0; dt < 2; ++dt)
#pragma unroll
                    for (int rg = 0; rg < 16; ++rg) { otot[dt][rg] += f * o[dt][rg]; o[dt][rg] = 0.f; }
                m = NEGBIG; l = 0.f; curkind = kind;
            }
            ldsp Kb = L + L3_BUF + (i & 1) * L3_BUFSZ, Vb = Kb + 9216;
            const bool wsel = (mysel >> j) & 1u;
            const bool active = (kind == 2) || (__any(wsel) != 0);
            if (active) {
                f32x16 s0 = f32x16{}, s1 = f32x16{};
#pragma unroll
                for (int s = 0; s < 4; ++s) {
                    s0 = __builtin_amdgcn_mfma_f32_32x32x16_bf16(lds_rd128(Kb + r32 * 144 + (2 * s + h) * 16), qf[s], s0, 0, 0, 0);
                    s1 = __builtin_amdgcn_mfma_f32_32x32x16_bf16(lds_rd128(Kb + (32 + r32) * 144 + (2 * s + h) * 16), qf[s], s1, 0, 0, 0);
                }
                float mb = NEGBIG;
#pragma unroll
                for (int rg = 0; rg < 16; ++rg) {
                    const int d0 = tq - (64 * j + crow(rg, h)), d1 = d0 - 32;
                    const bool v0 = (kind == 1) ? (wsel && d0 >= 0) : (d0 >= 0 && d0 < 512);
                    const bool v1 = (kind == 1) ? (wsel && d1 >= 0) : (d1 >= 0 && d1 < 512);
                    s0[rg] = v0 ? (s0[rg] * sc2 - slope2 * (float)d0) : NEGBIG;
                    s1[rg] = v1 ? (s1[rg] * sc2 - slope2 * (float)d1) : NEGBIG;
                    mb = fmaxf(mb, fmaxf(s0[rg], s1[rg]));
                }
                mb = fmaxf(mb, swap32(mb));
                const float mnew = fmaxf(m, mb);
                const float alpha = __builtin_amdgcn_exp2f(m - mnew);
                float ls = 0.f;
#pragma unroll
                for (int rg = 0; rg < 16; ++rg) {
                    const float p0 = (s0[rg] > -1e29f) ? __builtin_amdgcn_exp2f(s0[rg] - mnew) : 0.f;
                    const float p1 = (s1[rg] > -1e29f) ? __builtin_amdgcn_exp2f(s1[rg] - mnew) : 0.f;
                    s0[rg] = p0; s1[rg] = p1; ls += p0 + p1;
                }
                ls += swap32(ls);
                l = l * alpha + ls; m = mnew;
#pragma unroll
                for (int dt = 0; dt < 2; ++dt)
#pragma unroll
                    for (int rg = 0; rg < 16; ++rg) o[dt][rg] *= alpha;
#pragma unroll
                for (int ks = 0; ks < 4; ++ks) {
                    const int sb = (ks & 1) * 8;
                    u32x4 pw;
                    if (ks < 2) { pw.x = cvtpk(s0[sb], s0[sb + 1]); pw.y = cvtpk(s0[sb + 2], s0[sb + 3]); pw.z = cvtpk(s0[sb + 4], s0[sb + 5]); pw.w = cvtpk(s0[sb + 6], s0[sb + 7]); }
                    else        { pw.x = cvtpk(s1[sb], s1[sb + 1]); pw.y = cvtpk(s1[sb + 2], s1[sb + 3]); pw.z = cvtpk(s1[sb + 4], s1[sb + 5]); pw.w = cvtpk(s1[sb + 6], s1[sb + 7]); }
                    const bf16x8 pf = __builtin_bit_cast(bf16x8, pw);
#pragma unroll
                    for (int dt = 0; dt < 2; ++dt) {
                        ldsp vp = Vb + (16 * ks + 4 * h + q4) * 192 + (dt * 32 + 16 * g1 + 4 * p4) * 2;
                        o[dt] = __builtin_amdgcn_mfma_f32_32x32x16_bf16(tr_pair(vp, vp + 8 * 192), pf, o[dt], 0, 0, 0);
                    }
                }
            }
            if (more) {
                ldsp Kn = L + L3_BUF + ((i + 1) & 1) * L3_BUFSZ;
                lds_wr128(Kn + lrow * 144 + lch * 16, kreg);
                lds_wr128(Kn + 9216 + lrow * 192 + lch * 16, vreg);
            }
            __syncthreads();
        }
        {
            const float f = gate[2] * (l > 0.f ? 1.f / l : 0.f);
#pragma unroll
            for (int dt = 0; dt < 2; ++dt)
#pragma unroll
                for (int rg = 0; rg < 16; ++rg) otot[dt][rg] += f * o[dt][rg];
        }
    }
#pragma unroll
    for (int dt = 0; dt < 2; ++dt)
#pragma unroll
        for (int gq = 0; gq < 4; ++gq) {
            u32x2 w; w.x = cvtpk(otot[dt][4 * gq], otot[dt][4 * gq + 1]); w.y = cvtpk(otot[dt][4 * gq + 2], otot[dt][4 * gq + 3]);
            *(u32x2*)(mix + trow * DM + 512 + head * 64 + dt * 32 + 8 * gq + 4 * h) = w;
        }
    {
        const int cc = tid & 31, tg = tid >> 5;
        const int ch0 = g * 256 + cc * 8;
        const float* cw = A.in[2];
        float w0[8], w1[8], w2[8];
#pragma unroll
        for (int e = 0; e < 8; ++e) { w0[e] = cw[ch0 + e]; w1[e] = cw[512 + ch0 + e]; w2[e] = cw[1024 + ch0 + e]; }
        float cu[6][8];
#pragma unroll
        for (int i = 0; i < 6; ++i) {
            const int t = qt * 64 + tg * 4 + i - 2;
            if (t >= 0) {
                const u16* pr = proj + ((size_t)b * SEQ + t) * NPAD;
                const bf16x8 cv = *(const bf16x8*)(pr + C_C + ch0), uv = *(const bf16x8*)(pr + C_U + ch0);
#pragma unroll
                for (int e = 0; e < 8; ++e) cu[i][e] = bf2f((u16)cv[e]) * bf2f((u16)uv[e]);
            } else {
#pragma unroll
                for (int e = 0; e < 8; ++e) cu[i][e] = 0.f;
            }
        }
#pragma unroll
        for (int i = 0; i < 4; ++i) {
            const int t = qt * 64 + tg * 4 + i;
            const bf16x8 bv = *(const bf16x8*)(proj + ((size_t)b * SEQ + t) * NPAD + C_B + ch0);
            float y[8];
#pragma unroll
            for (int e = 0; e < 8; ++e) y[e] = bf2f((u16)bv[e]) * (w0[e] * cu[i][e] + w1[e] * cu[i + 1][e] + w2[e] * cu[i + 2][e]);
            u32x4 w; w.x = cvtpk(y[0], y[1]); w.y = cvtpk(y[2], y[3]); w.z = cvtpk(y[4], y[5]); w.w = cvtpk(y[6], y[7]);
            *(u32x4*)(mix + ((size_t)b * SEQ + t) * DM + ch0) = w;
        }
    }
}

__device__ __forceinline__ void p4_unit(const Args& A, ldsp L, const int panel) {
    const int tid = threadIdx.x, lane = tid & 63, wid = tid >> 6, h = lane >> 5, r32 = lane & 31;
    const int wm = wid >> 2, wn = wid & 3;
    const int m0 = panel * 128;
    const u16* mix = (const u16*)(A.ws + WS_MIX);
    float* ybuf = A.out;
    const float* x = A.in[0];
#pragma unroll 1
    for (int nc = 0; nc < 4; ++nc) {
        LdBf16<1> al; al.kstep = 32; al.p[0] = mix + (size_t)(m0 + (tid >> 2)) * DM + (tid & 3) * 8;
        LdBf16<2> bl; bl.kstep = (size_t)32 * DM;
        bl.p[0] = (const u16*)(A.ws + WS_WOUT) + (size_t)(tid >> 5) * DM + nc * 256 + (tid & 31) * 8; bl.p[1] = bl.p[0] + (size_t)16 * DM;
        f32x16 acc[2][2];
#pragma unroll
        for (int i = 0; i < 2; ++i)
#pragma unroll
            for (int j = 0; j < 2; ++j) acc[i][j] = f32x16{};
        gemm_core<128, 256, 2, 4, false>(acc, al, bl, DM / 32, L, L, 0);
        {
            LAS float* Tl = (LAS float*)L + (wm * 64 + 4 * h) * 260 + wn * 64 + r32;
#pragma unroll
            for (int mt = 0; mt < 2; ++mt)
#pragma unroll
                for (int nt = 0; nt < 2; ++nt)
#pragma unroll
                    for (int r = 0; r < 16; ++r) Tl[(mt * 32 + (r & 3) + 8 * (r >> 2)) * 260 + nt * 32] = acc[mt][nt][r];
            __syncthreads();
#pragma unroll 4
            for (int i = 0; i < 16; ++i) {
                const int idx = i * 512 + tid, row = idx >> 6, c4 = idx & 63;
                const f32x4 a = *(LAS f32x4*)((LAS float*)L + row * 260 + c4 * 4);
                const size_t gi = (size_t)(m0 + row) * DM + nc * 256 + c4 * 4;
                const f32x4 xv = *(const f32x4*)(x + gi);
                *(f32x4*)(ybuf + gi) = a + ALPHA * xv;
            }
            __syncthreads();
        }
    }
    VM_WAIT();
    __syncthreads();
    {
        const float* gam = A.in[12]; const float* bet = A.in[13];
        u16* x1h = (u16*)(A.ws + WS_X1H);
#pragma unroll 1
        for (int rr = 0; rr < 16; ++rr) {
            const size_t row = (size_t)m0 + wid * 16 + rr;
            f32x4 v[4]; float s = 0.f;
#pragma unroll
            for (int jj = 0; jj < 4; ++jj) { v[jj] = *(const f32x4*)(ybuf + row * DM + lane * 4 + 256 * jj); s += (v[jj].x + v[jj].y) + (v[jj].z + v[jj].w); }
            const float mean = wave_sum(s) * (1.f / 1024.f);
            float q = 0.f;
#pragma unroll
            for (int jj = 0; jj < 4; ++jj) { v[jj] = v[jj] - mean; q += (v[jj].x * v[jj].x + v[jj].y * v[jj].y) + (v[jj].z * v[jj].z + v[jj].w * v[jj].w); }
            const float rstd = rsqrtf(wave_sum(q) * (1.f / 1024.f) + LN_EPS);
#pragma unroll
            for (int jj = 0; jj < 4; ++jj) {
                const int c = lane * 4 + 256 * jj;
                const f32x4 gg = *(const f32x4*)(gam + c), bb = *(const f32x4*)(bet + c);
                const f32x4 o = v[jj] * rstd * gg + bb;
                *(f32x4*)(ybuf + row * DM + c) = o;
                u32x2 w; w.x = cvtpk(o.x, o.y); w.y = cvtpk(o.z, o.w);
                *(u32x2*)(x1h + row * DM + c) = w;
            }
        }
    }
    VM_WAIT();
    __syncthreads();
    {
        f32x16 acc[2][2];
#pragma unroll
        for (int i = 0; i < 2; ++i)
#pragma unroll
            for (int j = 0; j < 2; ++j) acc[i][j] = f32x16{};
#pragma unroll 1
        for (int pass = 0; pass < 3; ++pass) {
            LdSplitA al; al.p = ybuf + (size_t)(m0 + (tid >> 2)) * DM + (tid & 3) * 8; al.mode = (pass == 2) ? 1 : 0;
            LdBf16<2> bl; bl.kstep = (size_t)32 * 256;
            bl.p[0] = (const u16*)(A.ws + (pass == 1 ? WS_RWL : WS_RWH)) + (size_t)(tid >> 5) * 256 + (tid & 31) * 8; bl.p[1] = bl.p[0] + (size_t)16 * 256;
            gemm_core<128, 256, 2, 4, false>(acc, al, bl, DM / 32, L, L, 0);
        }
        LAS float* lg = (LAS float*)L;
#pragma unroll
        for (int mt = 0; mt < 2; ++mt)
#pragma unroll
            for (int nt = 0; nt < 2; ++nt)
#pragma unroll
                for (int r = 0; r < 16; ++r) lg[(wm * 64 + mt * 32 + crow(r, h)) * 257 + wn * 64 + nt * 32 + r32] = acc[mt][nt][r];
    }
    LAS int* hist = (LAS int*)(L + 131584);
    LAS int* ubase = (LAS int*)(L + 131584 + 1024);
    LAS int* rowe = (LAS int*)(L + 131584 + 2048);
    LAS int* rowr = (LAS int*)(L + 131584 + 2048 + 4096);
    if (tid < 256) hist[tid] = 0;
    __syncthreads();
    {
        const float* rbias = A.in[15];
        LAS float* lg = (LAS float*)L;
        int* tok_e = (int*)(A.ws + WS_TOKE); float* tok_w = (float*)(A.ws + WS_TOKW);
#pragma unroll 1
        for (int pass = 0; pass < 2; ++pass) {
            const int row = pass * 64 + (tid >> 3), gi = tid & 7;
            const size_t tok = (size_t)m0 + row;
            float bv[32];
            float m1 = -INFINITY, m2 = -INFINITY;
#pragma unroll
            for (int e = 0; e < 32; ++e) {
                const float sg = 1.f / (1.f + expf(-lg[row * 257 + gi * 32 + e]));
                const float v = sg + rbias[gi * 32 + e];
                bv[e] = v;
                if (v > m1) { m2 = m1; m1 = v; } else if (v > m2) m2 = v;
            }
            const float gs = m1 + m2;
            int rank = 0;
#pragma unroll
            for (int j = 0; j < 8; ++j) { const float o2 = __shfl(gs, (lane & ~7) | j); rank += (o2 > gs || (o2 == gs && j < gi)) ? 1 : 0; }
            const bool gsel = rank < 4;
            unsigned taken = 0u;
            int esel[8];
#pragma unroll
            for (int k = 0; k < 8; ++k) {
                float bvv = -INFINITY; int bi = 1 << 20;
                if (gsel) {
#pragma unroll
                    for (int e = 0; e < 32; ++e) { const bool ok = !((taken >> e) & 1u) && bv[e] > bvv; bvv = ok ? bv[e] : bvv; bi = ok ? (gi * 32 + e) : bi; }
                }
#pragma unroll
                for (int o = 1; o < 8; o <<= 1) {
                    const float ov = __shfl_xor(bvv, o); const int oi = __shfl_xor(bi, o);
                    const bool tk = (ov > bvv) || (ov == bvv && oi < bi);
                    bvv = tk ? ov : bvv; bi = tk ? oi : bi;
                }
                if ((bi >> 5) == gi) taken |= 1u << (bi & 31);
                esel[k] = bi;
            }
            if (gi == 0) {
                float sc[8], ssum = 0.f;
#pragma unroll
                for (int k = 0; k < 8; ++k) { sc[k] = 1.f / (1.f + expf(-lg[row * 257 + esel[k]])); ssum += sc[k]; }
#pragma unroll
                for (int k = 0; k < 8; ++k) {
                    tok_e[tok * 8 + k] = esel[k]; tok_w[tok * 8 + k] = sc[k] / ssum * 2.5f;
                    rowe[row * 8 + k] = esel[k];
                    rowr[row * 8 + k] = atomicAdd((int*)&hist[esel[k]], 1);
                }
            }
        }
    }
    __syncthreads();
    if (tid < 256) { const int c = hist[tid]; ubase[tid] = c ? atomicAdd((int*)(A.ws + WS_CNT) + tid, c) : 0; }
    __syncthreads();
    {
        int* tok_p = (int*)(A.ws + WS_TOKP);
        for (int i = tid; i < 1024; i += 512) tok_p[(size_t)m0 * 8 + i] = ubase[rowe[i]] + rowr[i];
    }
    __syncthreads();
}

__device__ __forceinline__ void p5_fill(const Args& A, ldsp L, int bid, int G) {
    const int tid = threadIdx.x;
    LAS int* base = (LAS int*)L;
    const int* cnt = (const int*)(A.ws + WS_CNT);
    if (tid == 0) { int s = 0; for (int e = 0; e < NEXP; ++e) { base[e] = s; s += cnt[e]; } }
    __syncthreads();
    const int* tok_e = (const int*)(A.ws + WS_TOKE); const float* tok_w = (const float*)(A.ws + WS_TOKW); const int* tok_p = (const int*)(A.ws + WS_TOKP);
    int* ssrc = (int*)(A.ws + WS_SSRC); float* sw = (float*)(A.ws + WS_SW);
    for (size_t i = (size_t)bid * 512 + tid; i < (size_t)T_TOK * 8; i += (size_t)G * 512) {
        const int d = base[tok_e[i]] + tok_p[i];
        ssrc[d] = (int)i; sw[d] = tok_w[i];
    }
    __syncthreads();
}

__device__ __forceinline__ void p6_moe(const Args& A, ldsp L, int vcu, int G) {
    const int tid = threadIdx.x, lane = tid & 63, wid = tid >> 6, h = lane >> 5, r32 = lane & 31;
    const int wm = wid >> 2, wn = wid & 3;
    constexpr int HST = 528;
    ldsp Hl = L + 57344;
    LAS int* tstart = (LAS int*)(L + 126464);
    LAS int* ebase = (LAS int*)(L + 126464 + 1040);
    LAS int* rtok = (LAS int*)(L + 124928);
    LAS int* rsrc = (LAS int*)(L + 124928 + 512);
    LAS float* rwt = (LAS float*)(L + 124928 + 1024);
    const int* cnt = (const int*)(A.ws + WS_CNT);
    if (tid == 0) { int s = 0, t = 0; for (int e = 0; e < NEXP; ++e) { ebase[e] = s; tstart[e] = t; s += cnt[e]; t += (cnt[e] + 127) >> 7; } tstart[NEXP] = t; }
    __syncthreads();
    const int nrt = tstart[NEXP], ntiles = nrt + T_TOK / 128;
    const int* ssrc = (const int*)(A.ws + WS_SSRC); const float* sw = (const float*)(A.ws + WS_SW);
    const u16* x1h = (const u16*)(A.ws + WS_X1H);
    for (int tile = vcu; tile < ntiles; tile += G) {
        int e, r0, nrows;
        if (tile < nrt) { int lo = 0, hi = NEXP - 1; while (lo < hi) { const int mid = (lo + hi + 1) >> 1; if (tstart[mid] <= tile) lo = mid; else hi = mid - 1; } e = lo; r0 = (tile - tstart[e]) * 128; nrows = cnt[e] - r0; if (nrows > 128) nrows = 128; }
        else { e = NEXP; r0 = (tile - nrt) * 128; nrows = 128; }
        if (tid < 128) {
            int tk, sr; float w;
            if (e < NEXP) { const int rr = tid < nrows ? tid : 0; const int s = ssrc[ebase[e] + r0 + rr]; tk = s >> 3; sr = tid < nrows ? (tk * 16 + (s & 7)) : -1; w = tid < nrows ? sw[ebase[e] + r0 + rr] : 0.f; }
            else { tk = r0 + tid; sr = tk * 16 + 8; w = 1.f; }
            rtok[tid] = tk; rsrc[tid] = sr; rwt[tid] = w;
        }
        __syncthreads();
        const float* wg = e < NEXP ? A.in[16] + (size_t)e * 1024 * 256 : A.in[19];
        const float* wu = e < NEXP ? A.in[17] + (size_t)e * 1024 * 256 : A.in[20];
        const float* wd = e < NEXP ? A.in[18] + (size_t)e * 256 * 1024 : A.in[21];
#pragma unroll 1
        for (int c = 0; c < 2; ++c) {
            LdBf16<1> al; al.kstep = 32; al.p[0] = x1h + (size_t)rtok[tid >> 2] * DM + (tid & 3) * 8;
            LdF32<2> bl; bl.kstep = (size_t)32 * 256;
#pragma unroll
            for (int i = 0; i < 2; ++i) {
                const int q = tid + 512 * i, bk = q >> 5, bn = q & 31;
                const int wnn = bn >> 3, half = (bn >> 2) & 1, j8 = bn & 3;
                bl.p[i] = (half ? wu : wg) + (size_t)bk * 256 + c * 128 + wnn * 32 + j8 * 8;
            }
            f32x16 acc[2][2];
#pragma unroll
            for (int i = 0; i < 2; ++i)
#pragma unroll
                for (int j = 0; j < 2; ++j) acc[i][j] = f32x16{};
            gemm_core<128, 256, 2, 4, false>(acc, al, bl, DM / 32, L, L, 0);
#pragma unroll
            for (int mt = 0; mt < 2; ++mt)
#pragma unroll
                for (int r = 0; r < 16; ++r) {
                    const int row = wm * 64 + mt * 32 + crow(r, h);
                    const float gv = acc[mt][0][r], uv = acc[mt][1][r];
                    const float hv = gv / (1.f + __expf(-gv)) * uv * rwt[row];
                    *(LAS u16*)(Hl + row * HST + (c * 128 + wn * 32 + r32) * 2) = f2bf(hv);
                }
        }
        __syncthreads();
#pragma unroll 1
        for (int nc = 0; nc < 4; ++nc) {
            LdBf16<1> al; al.kstep = 0; al.p[0] = x1h;
            LdF32<2> bl; bl.kstep = (size_t)32 * 1024;
#pragma unroll
            for (int i = 0; i < 2; ++i) { const int q = tid + 512 * i; bl.p[i] = wd + (size_t)(q >> 5) * 1024 + nc * 256 + (q & 31) * 8; }
            f32x16 acc[2][2];
#pragma unroll
            for (int i = 0; i < 2; ++i)
#pragma unroll
                for (int j = 0; j < 2; ++j) acc[i][j] = f32x16{};
            gemm_core<128, 256, 2, 4, true>(acc, al, bl, 256 / 32, L, Hl, HST);
#pragma unroll
            for (int mt = 0; mt < 2; ++mt)
#pragma unroll
                for (int r = 0; r < 16; ++r) {
                    const int row = wm * 64 + mt * 32 + crow(r, h);
                    const int sr = rsrc[row];
                    if (sr >= 0) {
                        const int tk = sr >> 4, slot = sr & 15;
                        u16* dst = slot < 7 ? (u16*)(A.ws + WS_Y + (size_t)slot * 128 * MiB) + (size_t)tk * DM
                                            : (u16*)((unsigned char*)A.out + (size_t)tk * 4096 + (slot - 7) * 2048);
#pragma unroll
                        for (int nt = 0; nt < 2; ++nt) dst[nc * 256 + wn * 64 + nt * 32 + r32] = f2bf(acc[mt][nt][r]);
                    }
                }
        }
        __syncthreads();
    }
}

__device__ __forceinline__ void p7_final(const Args& A, int bid, int G) {
    const int tid = threadIdx.x, lane = tid & 63, wid = tid >> 6;
    const u16* x1h = (const u16*)(A.ws + WS_X1H);
    const float* gam = A.in[22]; const float* bet = A.in[23];
    for (int row = bid * 8 + wid; row < T_TOK; row += G * 8) {
        float v[16];
        {
            const bf16x8 a = *(const bf16x8*)(x1h + (size_t)row * DM + lane * 8), b = *(const bf16x8*)(x1h + (size_t)row * DM + 512 + lane * 8);
#pragma unroll
            for (int e = 0; e < 8; ++e) { v[e] = ALPHA * bf2f((u16)a[e]); v[8 + e] = ALPHA * bf2f((u16)b[e]); }
        }
#pragma unroll
        for (int s = 0; s < 9; ++s) {
            const u16* src = s < 7 ? (const u16*)(A.ws + WS_Y + (size_t)s * 128 * MiB) + (size_t)row * DM
                                   : (const u16*)((const unsigned char*)A.out + (size_t)row * 4096 + (s - 7) * 2048);
            const bf16x8 a = *(const bf16x8*)(src + lane * 8), b = *(const bf16x8*)(src + 512 + lane * 8);
#pragma unroll
            for (int e = 0; e < 8; ++e) { v[e] += bf2f((u16)a[e]); v[8 + e] += bf2f((u16)b[e]); }
        }
        float s = 0.f;
#pragma unroll
        for (int e = 0; e < 16; ++e) s += v[e];
        const float mean = wave_sum(s) * (1.f / 1024.f);
        float q = 0.f;
#pragma unroll
        for (int e = 0; e < 16; ++e) { v[e] -= mean; q += v[e] * v[e]; }
        const float rstd = rsqrtf(wave_sum(q) * (1.f / 1024.f) + LN_EPS);
        float* o = A.out + (size_t)row * DM;
#pragma unroll
        for (int hh = 0; hh < 2; ++hh)
#pragma unroll
            for (int q4i = 0; q4i < 2; ++q4i) {
                const int c = hh * 512 + lane * 8 + q4i * 4;
                const f32x4 gg = *(const f32x4*)(gam + c), bb = *(const f32x4*)(bet + c);
                f32x4 r; r.x = v[hh * 8 + q4i * 4] * rstd * gg.x + bb.x; r.y = v[hh * 8 + q4i * 4 + 1] * rstd * gg.y + bb.y; r.z = v[hh * 8 + q4i * 4 + 2] * rstd * gg.z + bb.z; r.w = v[hh * 8 + q4i * 4 + 3] * rstd * gg.w + bb.w;
                *(f32x4*)(o + c) = r;
            }
    }
}

__global__ void __launch_bounds__(512, 2) fwd_kernel(Args A) {
    extern __shared__ __attribute__((aligned(16))) unsigned char lds_raw[];
    ldsp L = (ldsp)lds_raw;
    const int tid = threadIdx.x, G = gridDim.x, bid = blockIdx.x;
    const int vcu = (G % 8 == 0) ? (bid % 8) * (G / 8) + bid / 8 : bid;
    volatile LAS unsigned* barw = (volatile LAS unsigned*)(L + LDS_BARW);
    if (tid < 4) barw[tid] = 0u;
    __syncthreads();
    XcdBarrier bar; bar.bar = (unsigned*)(A.ws + WS_BAR); bar.x = 0; bar.st = barw;
    if (N_LAUNCHES == 1) bar = xcd_barrier_post((unsigned*)(A.ws + WS_BAR), barw);
    const int lo = A.ph_lo, hi = A.ph_hi;
#define IN(k) (lo <= (k) && (k) < hi)
#define SEAM(k) do { if (IN(k) && IN((k) + 1)) xcd_barrier(bar); } while (0)

    if (IN(0)) { p0_prologue(A, L); }
    SEAM(0);
    if (IN(1)) { p1_proj(A, L, vcu, G); }
    SEAM(1);
    if (IN(2)) { p2_compress(A, L, bid, G); }
    SEAM(2);
    if (IN(3)) {
        for (int i = 0; i * G + vcu < 2048; ++i) {
            const int u = i * G + vcu; const int bg = u >> 5, qr = u & 31;
            const int qt = (i & 1) ? 31 - qr : qr;
            int z = 0; asm volatile("" : "+v"(z));
            p3_unit(A, L, bg >> 1, bg & 1, qt, z);
            __syncthreads();
        }
    }
    SEAM(3);
    if (IN(4)) { for (int p = vcu; p < T_TOK / 128; p += G) p4_unit(A, L, p); }
    SEAM(4);
    if (IN(5)) { p5_fill(A, L, bid, G); }
    SEAM(5);
    if (IN(6)) { p6_moe(A, L, vcu, G); }
    SEAM(6);
    if (IN(7)) { p7_final(A, bid, G); }
#undef IN
#undef SEAM
}

extern "C" void kernel_launch(void* const* d_in, const int* in_sizes, int n_in, void* d_out, int out_size, void* d_ws, size_t ws_size, hipStream_t stream) {
    static int grid = 0;
    if (grid == 0) {
        if (n_in != 24 || out_size != T_TOK * DM || ws_size < WS_END) { fprintf(stderr, "kernel_launch: unexpected problem (n_in %d out %d ws %zu)\n", n_in, out_size, ws_size); grid = -1; return; }
        int dev = 0, cus = 0;
        if (hipGetDevice(&dev) != hipSuccess || hipDeviceGetAttribute(&cus, hipDeviceAttributeMultiprocessorCount, dev) != hipSuccess) { grid = -1; return; }
        if (hipFuncSetAttribute((const void*)fwd_kernel, hipFuncAttributeMaxDynamicSharedMemorySize, LDS_BYTES) != hipSuccess) { fprintf(stderr, "kernel_launch: hipFuncSetAttribute failed\n"); grid = -1; return; }
        int per_cu = 0;
        if (hipOccupancyMaxActiveBlocksPerMultiprocessor(&per_cu, (const void*)fwd_kernel, 512, LDS_BYTES) != hipSuccess || per_cu < 1) { fprintf(stderr, "kernel_launch: occupancy query says %d\n", per_cu); }
        (void)hipGetLastError();
        grid = cus;
    }
    if (grid < 0) return;
    (void)hipMemsetAsync(d_ws, 0, WS_ZERO_BYTES, stream);
    Args a{};
    for (int i = 0; i < 24; ++i) a.in[i] = (const float*)d_in[i];
    a.out = (float*)d_out; a.ws = (unsigned char*)d_ws;
    if (N_LAUNCHES == 1) {
        a.ph_lo = 0; a.ph_hi = 8;
        hipLaunchKernelGGL(fwd_kernel, dim3(grid), dim3(512), LDS_BYTES, stream, a);
    } else {
        for (int p = 0; p < 8; ++p) { a.ph_lo = p; a.ph_hi = p + 1; hipLaunchKernelGGL(fwd_kernel, dim3(grid), dim3(512), LDS_BYTES, stream, a); }
    }
}
```

```cpp
#include <hip/hip_runtime.h>
#include <stdint.h>
#include <stdio.h>

#ifndef N_LAUNCHES
#define N_LAUNCHES 1
#endif

#define LAS __attribute__((address_space(3)))
typedef unsigned short u16;
typedef short bf16x8 __attribute__((ext_vector_type(8)));
typedef short s16x4 __attribute__((ext_vector_type(4)));
typedef short v4i16_t __attribute__((ext_vector_type(4)));
typedef float f32x16 __attribute__((ext_vector_type(16)));
typedef float f32x4 __attribute__((ext_vector_type(4)));
typedef unsigned u32x4 __attribute__((ext_vector_type(4)));
typedef unsigned u32x2 __attribute__((ext_vector_type(2)));
typedef int i32x4 __attribute__((ext_vector_type(4)));
typedef int i32x8 __attribute__((ext_vector_type(8)));
typedef float f32x2_t __attribute__((ext_vector_type(2)));
typedef __bf16 bf16x2_t __attribute__((ext_vector_type(2)));
typedef LAS char* ldsp;

constexpr int T_TOK = 65536, DM = 1024, SEQ = 2048;
constexpr int NPROJ = 2840, NPAD = 2944;
constexpr int C_B = 0, C_C = 512, C_U = 1024, C_Q = 1536, C_KC = 2048, C_VC = 2176, C_KS = 2304, C_VS = 2432, C_KW = 2560, C_VW = 2688, C_GL = 2816;
constexpr float ALPHA = 1.189207115002721f;
constexpr float LOG2E = 1.4426950408889634f;
constexpr float LN_EPS = 1e-5f;
constexpr int NEXP = 256;

constexpr size_t MiB = 1ull << 20;
constexpr size_t WS_BAR = 0;
constexpr size_t WS_P7Q = 24576;
constexpr size_t WS_CNT = 16384;
constexpr size_t WS_ZERO_BYTES = 32768;
constexpr size_t WS_TOKE = 1 * MiB;
constexpr size_t WS_TOKW = 3 * MiB;
constexpr size_t WS_TOKP = 5 * MiB;
constexpr size_t WS_SSRC = 396 * MiB;
constexpr int ECAP = 65536;
constexpr size_t WS_X1H  = 12 * MiB;
constexpr size_t WS_WGU8 = 140 * MiB;
constexpr size_t WS_WD8  = 268 * MiB;
constexpr size_t WS_X1F  = 332 * MiB;
constexpr size_t WS_Y    = 524 * MiB;
constexpr int NPASS = 1, TPP = T_TOK / NPASS;
constexpr size_t YSLOT   = (size_t)TPP * 1024;
constexpr float YSCALE = 32.f, YINV = 1.f / 32.f;
constexpr size_t YBUF = (NPASS > 1) ? 7 * YSLOT : 0;
constexpr size_t WS_HS   = 972 * MiB;
constexpr size_t WS_WSH  = 1032 * MiB;
constexpr size_t WS_END  = 1034 * MiB;
constexpr size_t WS_XB   = 524 * MiB;
constexpr size_t WS_MIX  = 524 * MiB;
constexpr size_t WS_PROJ = 652 * MiB;
constexpr size_t WS_YMIX = 864 * MiB;
constexpr size_t WS_LGS  = 800 * MiB;
constexpr size_t WS_X1L  = 652 * MiB;
constexpr size_t WS_WIN  = 1020 * MiB;
constexpr size_t WS_WOUT = 1026 * MiB;
constexpr size_t WS_RWH  = 1028 * MiB;
constexpr size_t WS_RWL  = 1028 * MiB + 512 * 1024;
constexpr size_t WS_CW1  = 1029 * MiB;
constexpr size_t WS_CB   = 1029 * MiB + 512 * 1024;
constexpr size_t WS_KCMP = 1030 * MiB;
constexpr size_t WS_VCMP = 1031 * MiB;

constexpr int LDS_BYTES = 161792;
constexpr int LDS_BARW = LDS_BYTES - 16;

__device__ __forceinline__ unsigned cvtpk(float lo, float hi) { f32x2_t v = {lo, hi}; bf16x2_t b = __builtin_convertvector(v, bf16x2_t); return __builtin_bit_cast(unsigned, b); }
__device__ __forceinline__ u16 f2bf(float f) { return (u16)(cvtpk(f, 0.f) & 0xffffu); }
__device__ __forceinline__ float bf2f(u16 b) { return __uint_as_float(((unsigned)b) << 16); }
__device__ __forceinline__ bf16x8 lds_rd128(ldsp p) { return *(LAS bf16x8*)p; }
__device__ __forceinline__ void lds_wr128(ldsp p, bf16x8 v) { *(LAS bf16x8*)p = v; }
__device__ __forceinline__ s16x4 lds_tr(ldsp p) { return __builtin_bit_cast(s16x4, __builtin_amdgcn_ds_read_tr16_b64_v4i16((LAS v4i16_t*)p)); }
__device__ __forceinline__ bf16x8 tr_pair(ldsp p0, ldsp p1) { s16x4 lo = lds_tr(p0), hi = lds_tr(p1); return (bf16x8){lo[0], lo[1], lo[2], lo[3], hi[0], hi[1], hi[2], hi[3]}; }
__device__ __forceinline__ float swap32(float v) { return __shfl_xor(v, 32); }
__device__ __forceinline__ float max_halves(float v) { auto rr = __builtin_amdgcn_permlane32_swap(__float_as_uint(v), __float_as_uint(v), false, false); return fmaxf(__uint_as_float(rr[0]), __uint_as_float(rr[1])); }
__device__ __forceinline__ float sum_halves(float v) { auto rr = __builtin_amdgcn_permlane32_swap(__float_as_uint(v), __float_as_uint(v), false, false); return __uint_as_float(rr[0]) + __uint_as_float(rr[1]); }
__device__ __forceinline__ float wave_sum(float v) {
#pragma unroll
    for (int o = 32; o >= 1; o >>= 1) v += __shfl_xor(v, o);
    return v;
}
__device__ __forceinline__ int crow(int r, int h) { return (r & 3) + 8 * (r >> 2) + 4 * h; }
#define VM_WAIT() asm volatile("s_waitcnt vmcnt(0)" ::: "memory")
__device__ __forceinline__ int tid_l() { int t = threadIdx.x; asm volatile("" : "+v"(t)); return t; }

struct RawF32 { f32x4 a, b; };
__device__ __forceinline__ bf16x8 cvt8(const RawF32& r) {
    u32x4 w; w.x = cvtpk(r.a.x, r.a.y); w.y = cvtpk(r.a.z, r.a.w); w.z = cvtpk(r.b.x, r.b.y); w.w = cvtpk(r.b.z, r.b.w);
    return __builtin_bit_cast(bf16x8, w);
}

template <int N> struct LdBf16 {
    const u16* p[N]; size_t kstep; typedef bf16x8 Raw;
    __device__ __forceinline__ Raw load(int i, int kt) const { return *(const bf16x8*)(p[i] + (size_t)kt * kstep); }
    __device__ __forceinline__ bf16x8 cvt(const Raw& r) const { return r; }
};
template <int N> struct LdF32 {
    const float* p[N]; size_t kstep; typedef RawF32 Raw;
    __device__ __forceinline__ Raw load(int i, int kt) const { const f32x4* q = (const f32x4*)(p[i] + (size_t)kt * kstep); RawF32 r; r.a = q[0]; r.b = q[1]; return r; }
    __device__ __forceinline__ bf16x8 cvt(const Raw& r) const { return cvt8(r); }
};
struct LdCmpA {
    const u16* p; typedef bf16x8 Raw;
    __device__ __forceinline__ Raw load(int, int kt) const { return *(const bf16x8*)(p + (size_t)(kt >> 1) * NPAD + (kt & 1) * 32); }
    __device__ __forceinline__ bf16x8 cvt(const Raw& r) const { return r; }
};
struct LdSplitA {
    const float* p; int mode; typedef RawF32 Raw;
    __device__ __forceinline__ Raw load(int, int kt) const { const f32x4* q = (const f32x4*)(p + kt * 32); RawF32 r; r.a = q[0]; r.b = q[1]; return r; }
    __device__ __forceinline__ bf16x8 cvt(const Raw& r) const {
        if (mode == 0) return cvt8(r);
        RawF32 d;
#pragma unroll
        for (int i = 0; i < 4; ++i) { d.a[i] = r.a[i] - bf2f(f2bf(r.a[i])); d.b[i] = r.b[i] - bf2f(f2bf(r.b[i])); }
        return cvt8(d);
    }
};

template <int BM, int BN, int WM, int WN, bool A_RES, class AL, class BL>
__device__ __forceinline__ void gemm_core(f32x16 (&acc)[BM / (WM * 32)][BN / (WN * 32)], const AL& al, const BL& bl, const int nk, ldsp st, ldsp ares, const int ares_stride) {
    constexpr int MT = BM / (WM * 32), NT = BN / (WN * 32);
    constexpr int NA = A_RES ? 0 : (BM * 4) / 512;
    constexpr int BCH = 32 * (BN / 8);
    constexpr int NBC = (BCH + 511) / 512;
    constexpr int AST = 80, BST = BN * 2 + 64;
    constexpr int ABYTES = A_RES ? 0 : BM * AST, BBYTES = 32 * BST, STAGE = ABYTES + BBYTES;
    static_assert(WM * WN == 8 && (A_RES || BM >= 128), "geometry");
    const int tid = tid_l(), lane = tid & 63, wid = tid >> 6;
    const int wm = wid / WN, wn = wid % WN, h = lane >> 5, r32 = lane & 31;
    const int q4 = (lane & 15) >> 2, p4 = lane & 3, g1 = (lane >> 4) & 1;
    const bool bact = (BCH >= 512) || (tid < BCH);
    int adst[NA > 0 ? NA : 1], bdst[NBC];
#pragma unroll
    for (int i = 0; i < NA; ++i) adst[i] = ((tid >> 2) + 128 * i) * AST + (tid & 3) * 16;
#pragma unroll
    for (int i = 0; i < NBC; ++i) { const int q = tid + 512 * i; bdst[i] = ABYTES + (q / (BN / 8)) * BST + (q % (BN / 8)) * 16; }
    const int afrag0 = A_RES ? ((wm * MT * 32 + r32) * ares_stride + h * 16) : ((wm * MT * 32 + r32) * AST + h * 16);
    const int bfrag0 = ABYTES + (8 * h + q4) * BST + (wn * NT * 32 + 16 * g1 + 4 * p4) * 2;
    typename AL::Raw ra[NA > 0 ? NA : 1]; typename BL::Raw rb[NBC];
#pragma unroll
    for (int i = 0; i < NA; ++i) ra[i] = al.load(i, 0);
    if (bact) {
#pragma unroll
        for (int i = 0; i < NBC; ++i) rb[i] = bl.load(i, 0);
    }
#pragma unroll
    for (int i = 0; i < NA; ++i) lds_wr128(st + adst[i], al.cvt(ra[i]));
    if (bact) {
#pragma unroll
        for (int i = 0; i < NBC; ++i) lds_wr128(st + bdst[i], bl.cvt(rb[i]));
    }
    __syncthreads();
    for (int kt = 0; kt < nk; ++kt) {
        ldsp cur = st + (kt & 1) * STAGE, nxt = st + ((kt & 1) ^ 1) * STAGE;
        const bool more = kt + 1 < nk;
        if (more) {
#pragma unroll
            for (int i = 0; i < NA; ++i) ra[i] = al.load(i, kt + 1);
            if (bact) {
#pragma unroll
                for (int i = 0; i < NBC; ++i) rb[i] = bl.load(i, kt + 1);
            }
        }
#pragma unroll
        for (int s = 0; s < 2; ++s) {
            bf16x8 af[MT], bfr[NT];
#pragma unroll
            for (int mt = 0; mt < MT; ++mt)
                af[mt] = A_RES ? lds_rd128(ares + afrag0 + mt * 32 * ares_stride + kt * 64 + s * 32) : lds_rd128(cur + afrag0 + mt * 32 * AST + s * 32);
#pragma unroll
            for (int nt = 0; nt < NT; ++nt)
                bfr[nt] = tr_pair(cur + bfrag0 + (16 * s) * BST + nt * 64, cur + bfrag0 + (16 * s + 4) * BST + nt * 64);
#pragma unroll
            for (int mt = 0; mt < MT; ++mt)
#pragma unroll
                for (int nt = 0; nt < NT; ++nt) acc[mt][nt] = __builtin_amdgcn_mfma_f32_32x32x16_bf16(af[mt], bfr[nt], acc[mt][nt], 0, 0, 0);
        }
        if (more) {
#pragma unroll
            for (int i = 0; i < NA; ++i) lds_wr128(nxt + adst[i], al.cvt(ra[i]));
            if (bact) {
#pragma unroll
                for (int i = 0; i < NBC; ++i) lds_wr128(nxt + bdst[i], bl.cvt(rb[i]));
            }
        }
        __syncthreads();
    }
}

#define WAIT_V(n) asm volatile("s_waitcnt vmcnt(" #n ")" ::: "memory")
#define WAIT_L0() asm volatile("s_waitcnt lgkmcnt(0)" ::: "memory")
__device__ __forceinline__ void glds16(const void* gsrc, unsigned lds_dst) { unsigned keep;
    asm volatile("s_mov_b32 %0, m0\n\ts_mov_b32 m0, %2\n\ts_nop 0\n\tglobal_load_lds_dwordx4 %1, off\n\ts_mov_b32 m0, %0" : "=&s"(keep) : "v"(gsrc), "s"(lds_dst) : "memory"); }
__device__ __forceinline__ void wait_vm(const int n) {
    switch (n) {
        case 0: WAIT_V(0); break;
        case 1: WAIT_V(1); break;
        case 2: WAIT_V(2); break;
        case 3: WAIT_V(3); break;
        case 4: WAIT_V(4); break;
        case 5: WAIT_V(5); break;
        case 6: WAIT_V(6); break;
        case 7: WAIT_V(7); break;
        case 8: WAIT_V(8); break;
        case 9: WAIT_V(9); break;
        case 10: WAIT_V(10); break;
        case 11: WAIT_V(11); break;
        case 12: WAIT_V(12); break;
        case 13: WAIT_V(13); break;
        case 14: WAIT_V(14); break;
        case 15: WAIT_V(15); break;
        case 16: WAIT_V(16); break;
        case 17: WAIT_V(17); break;
        case 18: WAIT_V(18); break;
        case 19: WAIT_V(19); break;
        case 20: WAIT_V(20); break;
        case 21: WAIT_V(21); break;
        case 22: WAIT_V(22); break;
        case 23: WAIT_V(23); break;
        case 24: WAIT_V(24); break;
        default: WAIT_V(0); break;
    }
}
constexpr int RING_STAGE = 32768, RING_BYTES = 3 * RING_STAGE, STG_OFF = RING_BYTES, STG_BYTES = 36864, TBL_OFF = STG_OFF + STG_BYTES;
struct Seg { unsigned pa[2], pb; const u16* abase; const u16* bbase; size_t bstep, b16; int nk; };
template <class AF, class BF>
__device__ __forceinline__ Seg make_seg(const AF& af, const BF& bf, const int nk) {
    const int tid = tid_l(), lane = tid & 63, wid = tid >> 6;
    Seg s;
#pragma unroll
    for (int i = 0; i < 2; ++i) { const int row = 16 * (wid + 8 * i) + (lane >> 2); const int c = (lane & 3) ^ (3 * ((lane >> 5) & 1)); s.pa[i] = af.off(row) + c * 16; }
    { const int k = 2 * wid + (lane >> 5); const int pos = lane & 31; const int gk = (k & 3) | (((k >> 3) & 1) << 2); const int ch = ((((pos >> 1) ^ gk) << 1) | (pos & 1)); s.pb = bf.off(k, ch); }
    s.abase = af.base; s.bbase = bf.base; s.bstep = bf.kstep; s.b16 = bf.kstep >> 1; s.nk = nk;
    return s;
}
template <int MTN = 4>
__device__ __forceinline__ void seg_issue(const Seg& s, const int kk, const unsigned dst  ) {
    const char* ab = (const char*)(s.abase + (size_t)kk * 32); const char* bb = (const char*)(s.bbase + (size_t)kk * s.bstep);
    glds16(ab + s.pa[0], (unsigned)__builtin_amdgcn_readfirstlane((int)dst));
    if (MTN == 4) glds16(ab + s.pa[1], (unsigned)__builtin_amdgcn_readfirstlane((int)(dst + 8192)));
    glds16(bb + s.pb, (unsigned)__builtin_amdgcn_readfirstlane((int)(dst + 16384)));
    glds16(bb + s.b16 * 2 + s.pb, (unsigned)__builtin_amdgcn_readfirstlane((int)(dst + 16384 + 8192)));
}
template <int MTN = 4>
__device__ __forceinline__ void dma_begin(const Seg& s, ldsp ring, int& slot) {
    const int wid = __builtin_amdgcn_readfirstlane(tid_l() >> 6);
    const unsigned ra = (unsigned)(uintptr_t)ring + wid * 1024;
    slot = 0;
    seg_issue<MTN>(s, 0, ra);
    seg_issue<MTN>(s, 1, ra + RING_STAGE);
}
template <int MTN = 4>
__device__ __forceinline__ void dma_run(f32x4 (&acc)[4][2][2][2], const Seg& cur, const Seg& nxt, const bool hasnext, int& slot, ldsp ring, const int eops = 0) {
    const int tid = tid_l(), lane = tid & 63, wid = __builtin_amdgcn_readfirstlane(tid >> 6);
    const int wm = wid >> 2, wn = wid & 3, l15 = lane & 15, G = lane >> 4, q4 = l15 >> 2, p4 = lane & 3;
    const unsigned ra = (unsigned)(uintptr_t)ring + wid * 1024;
    int xoff[2], woff[2][2];
#pragma unroll
    for (int tb = 0; tb < 2; ++tb) xoff[tb] = (wm * 32 + tb * 16 + l15) * 64 + ((G ^ (3 * ((l15 >> 3) & 1))) * 16);
#pragma unroll
    for (int nt = 0; nt < 2; ++nt)
#pragma unroll
        for (int nb = 0; nb < 2; ++nb) woff[nt][nb] = 16384 + (8 * G + q4) * 512 + (((wn * 4 + nt * 2 + nb) ^ (q4 | ((G & 1) << 2))) * 32) + 8 * p4;
    const int nk = cur.nk;
    constexpr int LPS = (MTN == 4) ? 4 : 3;
    for (int kt = 0; kt < nk; ++kt) {
        if (kt + 1 < nk || hasnext) wait_vm(LPS + (kt < 2 ? eops : 0)); else WAIT_V(0);
        __builtin_amdgcn_s_barrier();
        ldsp cp = ring + slot * RING_STAGE;
        bf16x8 wf[2][2], xa[2], xb[2];
#pragma unroll
        for (int nt = 0; nt < 2; ++nt)
#pragma unroll
            for (int nb = 0; nb < 2; ++nb) wf[nt][nb] = tr_pair(cp + woff[nt][nb], cp + woff[nt][nb] + 2048);
        xa[0] = lds_rd128(cp + xoff[0]); xa[1] = lds_rd128(cp + xoff[1]);
        {
            const int k2 = kt + 2; int s2 = slot + 2; if (s2 >= 3) s2 -= 3;
            if (k2 < nk) seg_issue<MTN>(cur, k2, ra + s2 * RING_STAGE);
            else if (hasnext) seg_issue<MTN>(nxt, k2 - nk, ra + s2 * RING_STAGE);
        }
#pragma unroll
        for (int mt = 0; mt < MTN; ++mt) {
            if (mt + 1 < MTN) { xb[0] = lds_rd128(cp + xoff[0] + (mt + 1) * 4096); xb[1] = lds_rd128(cp + xoff[1] + (mt + 1) * 4096); }
            __builtin_amdgcn_s_setprio(1);
#pragma unroll
            for (int tb = 0; tb < 2; ++tb)
#pragma unroll
                for (int nt = 0; nt < 2; ++nt)
#pragma unroll
                    for (int nb = 0; nb < 2; ++nb) acc[mt][nt][tb][nb] = __builtin_amdgcn_mfma_f32_16x16x32_bf16(wf[nt][nb], xa[tb], acc[mt][nt][tb][nb], 0, 0, 0);
            __builtin_amdgcn_s_setprio(0);
            __builtin_amdgcn_sched_barrier(0);
            xa[0] = xb[0]; xa[1] = xb[1];
        }
        slot = (slot == 2) ? 0 : slot + 1;
    }
}
template <int NTC>
__device__ __forceinline__ void wave_transpose_bf16(const u32x2 (&q)[NTC][2][2], bf16x8 (&out)[NTC * 2], ldsp wbuf, int lane) {
    const int l15 = lane & 15, G = lane >> 4;
#pragma unroll
    for (int nt = 0; nt < NTC; ++nt)
#pragma unroll
        for (int tb = 0; tb < 2; ++tb)
#pragma unroll
            for (int nb = 0; nb < 2; ++nb) *(LAS u32x2*)(wbuf + (tb * 16 + l15) * 144 + (nt * 32 + nb * 16 + 4 * G) * 2) = q[nt][tb][nb];
    constexpr int LPR = 4 * NTC;
#pragma unroll
    for (int j = 0; j < NTC * 2; ++j) out[j] = lds_rd128(wbuf + (j * (64 / LPR) + lane / LPR) * 144 + (lane % LPR) * 16);
}
__device__ __forceinline__ void wave_transpose_f32(const f32x4 (&v)[2][2], f32x4 (&out)[4], ldsp wbuf, int lane) {
    const int l15 = lane & 15, G = lane >> 4;
#pragma unroll
    for (int tb = 0; tb < 2; ++tb)
#pragma unroll
        for (int nb = 0; nb < 2; ++nb) *(LAS f32x4*)(wbuf + (tb * 16 + l15) * 144 + (nb * 16 + 4 * G) * 4) = v[tb][nb];
#pragma unroll
    for (int j = 0; j < 4; ++j) out[j] = *(LAS f32x4*)(wbuf + (j * 8 + (lane >> 3)) * 144 + (lane & 7) * 16);
}

struct AFDense { const u16* base; size_t ld; __device__ __forceinline__ unsigned off(int row) const { return (unsigned)(row * (int)ld * 2); } };
struct BFDense { const u16* base; size_t ld; size_t kstep; __device__ __forceinline__ unsigned off(int k, int ch) const { return (unsigned)((k * (int)ld + ch * 8) * 2); } };
__device__ __forceinline__ void stage_round_bf16(const f32x16& v0, const f32x16& v1, ldsp stg, int wm, int wn, int h, int r32) {
    ldsp base = stg + (wm * 32 + 4 * h) * 512 + (wn * 64 + r32) * 2;
#pragma unroll
    for (int r = 0; r < 16; ++r) { *(LAS u16*)(base + ((r & 3) + 8 * (r >> 2)) * 512) = f2bf(v0[r]); *(LAS u16*)(base + ((r & 3) + 8 * (r >> 2)) * 512 + 64) = f2bf(v1[r]); }
}

#define XB_TMO      128
#define XB_XCNT(j)  (256  + 64 * (j))
#define XB_XSUB(j)  (1280 + 64 * (j))
#define XB_XGEN(j)  (2304 + 64 * (j))
#define XB_TOP      3328
#define XB_TOPGEN   3392
#define XCD_BAR_WORDS 3456
#define XB_SPIN_CAP (1u << 22)
__device__ __forceinline__ unsigned xb_ld(unsigned* p)              { return __hip_atomic_load(p, __ATOMIC_RELAXED, __HIP_MEMORY_SCOPE_AGENT); }
__device__ __forceinline__ unsigned xb_add(unsigned* p, unsigned v) { return __hip_atomic_fetch_add(p, v, __ATOMIC_RELAXED, __HIP_MEMORY_SCOPE_AGENT); }
__device__ __forceinline__ unsigned xb_xcc_id() { return (unsigned)__builtin_amdgcn_s_getreg((3 << 11) | 20) & 0xFu; }
#define XB_SPIN(cond, bar) do { unsigned _sp = 0; while (cond) { __builtin_amdgcn_s_sleep(1); \
    if ((++_sp & 255u) == 0u) { if (xb_ld(&(bar)[XB_TMO])) break; if (_sp > XB_SPIN_CAP) { atomicAdd(&(bar)[XB_TMO], 1u); break; } } } } while (0)
struct XcdBarrier { unsigned* bar; unsigned x; volatile LAS unsigned* st; };
__device__ __forceinline__ XcdBarrier xcd_barrier_post(unsigned* bar, volatile LAS unsigned* st) {
    XcdBarrier b; b.bar = bar; b.x = xb_xcc_id(); b.st = st;
    if (threadIdx.x == 0) (void)xb_add(&bar[XB_XCNT(b.x)], 1u);
    return b;
}
__device__ __forceinline__ void xcd_barrier_complete(unsigned* bar, unsigned x, unsigned& nloc, unsigned& nx) {
    const unsigned G = gridDim.x * gridDim.y * gridDim.z;
    unsigned sum, cnt, mine, sp = 0u;
    for (;;) {
        sum = 0u; cnt = 0u; mine = 0u;
#pragma unroll
        for (unsigned j = 0; j < 16; ++j) { const unsigned c = xb_ld(&bar[XB_XCNT(j)]); sum += c; cnt += (c > 0u) ? 1u : 0u; mine = (j == x) ? c : mine; }
        if (sum == G) break;
        __builtin_amdgcn_s_sleep(1);
        if ((++sp & 255u) == 0u) { if (xb_ld(&bar[XB_TMO])) break; if (sp > XB_SPIN_CAP) { atomicAdd(&bar[XB_TMO], 1u); break; } }
    }
    nloc = mine > 0u ? mine : 1u; nx = cnt > 0u ? cnt : 1u;
}
__device__ __forceinline__ void xcd_barrier(const XcdBarrier& b) {
    asm volatile("s_waitcnt vmcnt(0)" ::: "memory");
    __syncthreads();
    if (threadIdx.x == 0) {
        unsigned* bar = b.bar;
        __builtin_amdgcn_s_waitcnt(0);
        unsigned nloc = b.st[0], nx = b.st[1];
        if (nloc == 0u) { xcd_barrier_complete(bar, b.x, nloc, nx); b.st[0] = nloc; b.st[1] = nx; }
        const unsigned old = xb_add(&bar[XB_XSUB(b.x)], 1u);
        const unsigned gen = old / nloc;
        if (old + 1u == (gen + 1u) * nloc) {
            __builtin_amdgcn_fence(__ATOMIC_RELEASE, "agent");
            asm volatile("s_waitcnt vmcnt(0)" ::: "memory");
            const unsigned og = xb_add(&bar[XB_TOP], 1u);
            const unsigned tg = og / nx;
            if (og + 1u == (tg + 1u) * nx) xb_add(&bar[XB_TOPGEN], 1u);
            else XB_SPIN(xb_ld(&bar[XB_TOPGEN]) == tg, bar);
            __builtin_amdgcn_fence(__ATOMIC_ACQUIRE, "agent");
            xb_add(&bar[XB_XGEN(b.x)], 1u);
            asm volatile("s_waitcnt vmcnt(0)" ::: "memory");
        } else {
            XB_SPIN(xb_ld(&bar[XB_XGEN(b.x)]) == gen, bar);
            __builtin_amdgcn_fence(__ATOMIC_ACQUIRE, "agent");
            asm volatile("s_waitcnt vmcnt(0)" ::: "memory");
        }
    }
    __syncthreads();
}

struct Args {
    const float* in[24];
    float* out;
    unsigned char* ws;
    int ph_lo, ph_hi;
};

constexpr float W8SCALE = 32.f, H8SCALE = 8.f, M8SCALE = 8.f;
__device__ __forceinline__ unsigned pk4_fp8(float a, float b, float c, float d) {
    a = __builtin_amdgcn_fmed3f(a, -448.f, 448.f); b = __builtin_amdgcn_fmed3f(b, -448.f, 448.f); c = __builtin_amdgcn_fmed3f(c, -448.f, 448.f); d = __builtin_amdgcn_fmed3f(d, -448.f, 448.f);
    int w = __builtin_amdgcn_cvt_pk_fp8_f32(a, b, 0, false); w = __builtin_amdgcn_cvt_pk_fp8_f32(c, d, w, true); return (unsigned)w; }
__device__ __forceinline__ size_t wcv_dst(const unsigned m, const unsigned off) {
    const unsigned e = off >> 15, rem = off & 32767u;
    if (m < 2) { const unsigned k = rem >> 5, n = (rem & 31u) * 8; return (size_t)e * 524288 + (size_t)(k * 512 + (n >> 7) * 256 + ((n >> 5) & 3u) * 64 + m * 32 + (n & 31u)); }
    const unsigned k = rem >> 7, n = (rem & 127u) * 8; return (size_t)e * 262144 + (size_t)(k * 1024 + n);
}
__device__ __forceinline__ RawF32 wcv_load_m(const float* mat, const unsigned m, const unsigned off) {
    const f32x4* src = (const f32x4*)mat + (size_t)off * 2;
    RawF32 r; r.a = __builtin_nontemporal_load(src); r.b = __builtin_nontemporal_load(src + 1); return r;
}
__device__ __forceinline__ void wcv_store_m(unsigned char* dgu, unsigned char* dd, const unsigned m, const unsigned off, const RawF32& r) {
    u32x2 w; w.x = pk4_fp8(r.a.x * W8SCALE, r.a.y * W8SCALE, r.a.z * W8SCALE, r.a.w * W8SCALE); w.y = pk4_fp8(r.b.x * W8SCALE, r.b.y * W8SCALE, r.b.z * W8SCALE, r.b.w * W8SCALE);
    __builtin_nontemporal_store(w, (u32x2*)((m < 2 ? dgu : dd) + wcv_dst(m, off)));
}

__device__ __forceinline__ void p0_prologue(const Args& A, ldsp L) {
    const int tid = tid_l(), G = gridDim.x, bid = blockIdx.x;
    const size_t gt = (size_t)bid * 512 + tid, gs = (size_t)G * 512;
    unsigned char* ws = A.ws;
    {
        const f32x4* src = (const f32x4*)A.in[0]; u32x4* dst = (u32x4*)(ws + WS_XB);
        const size_t n8 = (size_t)T_TOK * DM / 8;
        for (size_t i = gt; i < n8; i += gs) { const f32x4 a = src[2 * i], b = src[2 * i + 1]; u32x4 w; w.x = cvtpk(a.x, a.y); w.y = cvtpk(a.z, a.w); w.z = cvtpk(b.x, b.y); w.w = cvtpk(b.z, b.w); dst[i] = w; }
    }
    {
        const float* w = A.in[1]; u32x4* dst = (u32x4*)(ws + WS_WIN);
        const size_t n8 = (size_t)1024 * (3072 / 8);
        for (size_t i = gt; i < n8; i += gs) {
            const int k = (int)(i / (3072 / 8)), c8 = (int)(i % (3072 / 8));
            u32x4 o = {0u, 0u, 0u, 0u};
            if (c8 * 8 < NPROJ) { const float* s = w + (size_t)k * NPROJ + c8 * 8; o.x = cvtpk(s[0], s[1]); o.y = cvtpk(s[2], s[3]); o.z = cvtpk(s[4], s[5]); o.w = cvtpk(s[6], s[7]); }
            dst[i] = o;
        }
    }
    {
        const f32x4* src = (const f32x4*)A.in[11]; u32x2* dst = (u32x2*)(ws + WS_WOUT);
        const size_t n8 = (size_t)1024 * 1024 / 8;
        for (size_t i = gt; i < n8; i += gs) { const f32x4 a = src[2 * i], b = src[2 * i + 1]; u32x2 w; w.x = pk4_fp8(a.x * W8SCALE, a.y * W8SCALE, a.z * W8SCALE, a.w * W8SCALE); w.y = pk4_fp8(b.x * W8SCALE, b.y * W8SCALE, b.z * W8SCALE, b.w * W8SCALE); dst[i] = w; }
    }
    {
        const float* src = A.in[14]; u16* dh = (u16*)(ws + WS_RWH); u16* dl = (u16*)(ws + WS_RWL);
        for (size_t i = gt; i < (size_t)1024 * 256; i += gs) { const float v = src[i]; const u16 hb = f2bf(v); dh[i] = hb; dl[i] = f2bf(v - bf2f(hb)); }
    }
    {
        u16* d = (u16*)(ws + WS_CW1);
        for (size_t i = gt; i < (size_t)2 * 2048 * 64; i += gs) { const int kv = (int)(i >> 17); const size_t r = i & 131071; d[i] = f2bf((kv ? A.in[8] : A.in[4])[r]); }
    }
    {
        for (size_t i = gt; i < (size_t)3 * 32768; i += gs) {
            const unsigned m = (unsigned)(i >> 15), off = (unsigned)(i & 32767);
            const RawF32 r = wcv_load_m(A.in[19 + m], m, off);
            wcv_store_m(ws + WS_WSH, ws + WS_WSH + 524288, m, off, r);
        }
    }
    {
        u16* kc = (u16*)(ws + WS_KCMP); u16* vc = (u16*)(ws + WS_VCMP);
        for (size_t i = gt; i < (size_t)32 * 128; i += gs) { const int b = (int)(i >> 7), r = (int)(i & 127); kc[((size_t)(b * 128 + 127) * 2) * 64 + r] = 0; vc[((size_t)(b * 128 + 127) * 2) * 64 + r] = 0; }
    }
    for (int o = bid; o < 128; o += G) {
        LAS float* part = (LAS float*)L;
        const int kv = o >> 6, n = o & 63;
        const float* pos = kv ? A.in[7] : A.in[3]; const float* w1 = kv ? A.in[8] : A.in[4];
        float s = 0.f;
#pragma unroll
        for (int j = 0; j < 4; ++j) { const int kk = tid + 512 * j; s += pos[kk] * w1[(size_t)kk * 64 + n]; }
        s = wave_sum(s);
        if ((tid & 63) == 0) part[tid >> 6] = s;
        __syncthreads();
        if (tid == 0) { const float* b1 = kv ? A.in[9] : A.in[5]; float t = 0.f; for (int w = 0; w < 8; ++w) t += part[w]; ((float*)(ws + WS_CB))[o] = t + b1[n]; }
        __syncthreads();
    }
}

constexpr int NWIN = 3072;
__device__ __forceinline__ void p1_unit_of(int vcu, int i, int& pm, int& pn) {
    const int x = vcu >> 5, j = vcu & 31, q = i * 32 + j;
    const int grp = q / 96, qq = q % 96;
    pm = x * 32 + grp * 8 + (qq & 7); pn = qq >> 3;
}
__device__ __forceinline__ void p1_proj(const Args& A, ldsp L, int vcu, int G, const int mode = 0) {
    const int tid = tid_l(), lane = tid & 63, wid = tid >> 6, h = lane >> 5, r32 = lane & 31;
    const u16* xb = (const u16*)(A.ws + WS_XB); const u16* wp = (const u16*)(A.ws + WS_WIN); u16* proj = (u16*)(A.ws + WS_PROJ);
    constexpr int NTN = NWIN / 256;
    const int wm = wid >> 2, wn = wid & 3;
    const bool xorder = (G == 256);
    const int nun = (T_TOK / 256) * NTN;
    int nmine = 0; for (int u = vcu; u < nun; u += G) ++nmine;
    if (nmine == 0) return;
    int pm, pn;
    if (xorder) p1_unit_of(vcu, 0, pm, pn); else { pm = vcu / NTN; pn = vcu % NTN; }
    Seg cur = make_seg(AFDense{xb + (size_t)(mode == 2 ? 0 : pm) * 256 * DM, (size_t)DM}, BFDense{wp + (mode == 2 ? 0 : pn) * 256, (size_t)NWIN, (size_t)32 * NWIN}, DM / 32);
    int slot; dma_begin(cur, L, slot);
    int eprev = 0;
#pragma unroll 1
    for (int i = 0; i < nmine; ++i) {
        const bool hasnext = i + 1 < nmine;
        int pm2 = pm, pn2 = pn;
        if (hasnext) { if (xorder) p1_unit_of(vcu, i + 1, pm2, pn2); else { const int u2 = vcu + (i + 1) * G; pm2 = u2 / NTN; pn2 = u2 % NTN; } }
        const Seg nxt = make_seg(AFDense{xb + (size_t)(mode == 2 ? 0 : pm2) * 256 * DM, (size_t)DM}, BFDense{wp + (mode == 2 ? 0 : pn2) * 256, (size_t)NWIN, (size_t)32 * NWIN}, DM / 32);
        f32x4 acc[4][2][2][2];
#pragma unroll
        for (int a_ = 0; a_ < 4; ++a_)
#pragma unroll
            for (int b_ = 0; b_ < 2; ++b_) { acc[a_][b_][0][0] = f32x4{0.f, 0.f, 0.f, 0.f}; acc[a_][b_][0][1] = acc[a_][b_][0][0]; acc[a_][b_][1][0] = acc[a_][b_][0][0]; acc[a_][b_][1][1] = acc[a_][b_][0][0]; }
        dma_run(acc, cur, nxt, hasnext, slot, L, eprev);
        const int m0 = pm * 256, n0 = pn * 256;
        eprev = (mode == 0 && n0 + wn * 64 < NPAD) ? 16 : 0;
        if (mode == 0) {
            const int te_ = tid_l(), lane = te_ & 63, wid = te_ >> 6, wm = wid >> 2, wn = wid & 3;
            ldsp wbuf = L + STG_OFF + wid * 4608;
#pragma unroll
            for (int mt = 0; mt < 4; ++mt) {
                u32x2 q[2][2][2];
#pragma unroll
                for (int nt = 0; nt < 2; ++nt)
#pragma unroll
                    for (int tb = 0; tb < 2; ++tb)
#pragma unroll
                        for (int nb = 0; nb < 2; ++nb) { const f32x4 t_ = acc[mt][nt][tb][nb]; q[nt][tb][nb].x = cvtpk(t_.x, t_.y); q[nt][tb][nb].y = cvtpk(t_.z, t_.w); }
                bf16x8 o[4];
                wave_transpose_bf16<2>(q, o, wbuf, lane);
                const int col = n0 + wn * 64 + (lane & 7) * 8;
                if (col < NPAD) {
#pragma unroll
                    for (int j = 0; j < 4; ++j) *(bf16x8*)(proj + (size_t)(m0 + (2 * mt + wm) * 32 + j * 8 + (lane >> 3)) * NPAD + col) = o[j];
                }
            }
        } else { asm volatile("" :: "v"(acc[0][0]), "v"(acc[3][1])); }
        cur = nxt; pm = pm2; pn = pn2;
    }
}

__device__ __forceinline__ float gelu_tanh(float x) { const float u = 0.7978845608028654f * (x + 0.044715f * x * x * x); return 0.5f * x * (1.f + tanhf(u)); }
__device__ __forceinline__ void p2_compress(const Args& A, ldsp L, int bid, int G) {
    const int tid = tid_l(), lane = tid & 63, wid = tid >> 6, h = lane >> 5, r32 = lane & 31;
    const u16* proj = (const u16*)(A.ws + WS_PROJ);
    const int wm = wid >> 1, wn = wid & 1;
    for (int u = bid; u < 128; u += G) {
        const int kv = u >> 6, r0 = (u & 63) * 128;
        int rr = r0 + (tid >> 2); if (rr > 8127) rr = 8127;
        const int b = rr / 254, rem = rr % 254, ci = rem >> 1, g = rem & 1;
        LdCmpA al; al.p = proj + (size_t)(b * SEQ + 16 * ci) * NPAD + (kv ? C_VC : C_KC) + g * 64 + (tid & 3) * 8;
        LdBf16<1> bl; bl.kstep = 32 * 64;
        bl.p[0] = (const u16*)(A.ws + WS_CW1) + (size_t)kv * 2048 * 64 + (size_t)((tid & 255) >> 3) * 64 + (tid & 7) * 8;
        f32x16 acc[1][1]; acc[0][0] = f32x16{};
        gemm_core<128, 64, 4, 2, false>(acc, al, bl, 2048 / 32, L, L, 0);
        LAS float* hid = (LAS float*)(L + 32768);
        const float* cb = (const float*)(A.ws + WS_CB) + kv * 64;
#pragma unroll
        for (int r = 0; r < 16; ++r) { const int row = wm * 32 + crow(r, h), col = wn * 32 + r32; hid[row * 65 + col] = gelu_tanh(acc[0][0][r] + cb[col]); }
        __syncthreads();
        {
            const int row = tid >> 2, qd = tid & 3;
            const float* w2 = kv ? A.in[10] : A.in[6];
            float o[16];
#pragma unroll
            for (int j = 0; j < 16; ++j) o[j] = 0.f;
            for (int n = 0; n < 64; ++n) { const float hv = hid[row * 65 + n]; const float* wr = w2 + n * 64 + qd * 16;
#pragma unroll
                for (int j = 0; j < 16; ++j) o[j] += hv * wr[j]; }
            const int r2 = r0 + row;
            if (r2 < 8128) {
                const int b2 = r2 / 254, rem2 = r2 % 254, ci2 = rem2 >> 1, g2 = rem2 & 1;
                u16* dst = (u16*)(A.ws + (kv ? WS_VCMP : WS_KCMP)) + ((size_t)(b2 * 128 + ci2) * 2 + g2) * 64 + qd * 16;
                u32x4 w0, w1;
                w0.x = cvtpk(o[0], o[1]); w0.y = cvtpk(o[2], o[3]); w0.z = cvtpk(o[4], o[5]); w0.w = cvtpk(o[6], o[7]);
                w1.x = cvtpk(o[8], o[9]); w1.y = cvtpk(o[10], o[11]); w1.z = cvtpk(o[12], o[13]); w1.w = cvtpk(o[14], o[15]);
                *(u32x4*)dst = w0; *(u32x4*)(dst + 8) = w1;
            }
        }
        __syncthreads();
    }
}

constexpr int L3_KC = 0, L3_VC = 18432, L3_BUF = 0, L3_BUFSZ = 21504, L3_E = 43008, L3_F = 75776, L3_IMP = 108544, L3_SEL = 116736, L3_UNI = 116992, L3_JOBS = 117008, L3_NJOB = 117264;
constexpr float NEGBIG = -1e30f;

constexpr int WCV_PER_THREAD = 24;
__device__ __forceinline__ RawF32 wcv_load(const Args& A, const int unit, const int i, const int tid) {
    const int m = i >> 3;
    const f32x4* src = (const f32x4*)(m == 0 ? A.in[16] : (m == 1 ? A.in[17] : A.in[18])) + ((size_t)unit * 4096 + (size_t)(i & 7) * 512) * 2 + tid * 2;
    RawF32 r; r.a = __builtin_nontemporal_load(src); r.b = __builtin_nontemporal_load(src + 1); return r;
}
__device__ __forceinline__ void wcv_store(const Args& A, const int unit, const int i, const int tid, const RawF32& r) {
    const int m = i >> 3, e = unit >> 3, ru = (unit & 7) * 4096 + (i & 7) * 512;
    unsigned char* dst;
    if (m < 2) { const int n = (tid & 31) * 8; dst = A.ws + WS_WGU8 + (size_t)e * 524288 + (size_t)((ru >> 5) * 512 + m * 32) + (unsigned)((tid >> 5) * 512 + (n >> 7) * 256 + ((n >> 5) & 3) * 64 + (n & 31)); }
    else dst = A.ws + WS_WD8 + (size_t)e * 262144 + (size_t)((ru >> 7) * 1024) + (unsigned)((tid >> 7) * 1024 + (tid & 127) * 8);
    u32x2 w; w.x = pk4_fp8(r.a.x * W8SCALE, r.a.y * W8SCALE, r.a.z * W8SCALE, r.a.w * W8SCALE); w.y = pk4_fp8(r.b.x * W8SCALE, r.b.y * W8SCALE, r.b.z * W8SCALE, r.b.w * W8SCALE);
    __builtin_nontemporal_store(w, (u32x2*)dst);
}
__device__ __forceinline__ void p3_unit(const Args& A, ldsp L, const int b, const int g, const int qt, const int zlaunder, const int unit) {
    const int tid = threadIdx.x + zlaunder, lane = tid & 63, wid = tid >> 6, h = lane >> 5, r32 = lane & 31;
    const int q4 = (lane & 15) >> 2, p4 = lane & 3, g1 = (lane >> 4) & 1;
    const u16* proj = (const u16*)(A.ws + WS_PROJ);
    unsigned char* mix = A.ws + WS_MIX;
    const int r = wid >> 1, qh = wid & 1, head = g * 4 + r;
    const int ql = qh * 32 + r32, tq = qt * 64 + ql;
    const size_t trow = (size_t)b * SEQ + tq;
    const float slope2 = exp2f(-(float)(head + 1)) * LOG2E, sc2 = 0.125f * LOG2E;
    LAS unsigned* selm = (LAS unsigned*)(L + L3_SEL);
    LAS unsigned* uni = (LAS unsigned*)(L + L3_UNI);
    LAS int* jobs = (LAS int*)(L + L3_JOBS);
    LAS int* njobp = (LAS int*)(L + L3_NJOB);
    if (tid == 0) uni[0] = 0u;
    bf16x8 qf[4];
#pragma unroll
    for (int s = 0; s < 4; ++s) qf[s] = *(const bf16x8*)(proj + trow * NPAD + C_Q + head * 64 + 16 * s + 8 * h);
    float gate[3];
#pragma unroll
    for (int i = 0; i < 3; ++i) { const float x = bf2f(proj[trow * NPAD + C_GL + head * 3 + i]); gate[i] = 1.f / (1.f + __expf(-x)); }
    {
        const u16* kc = (const u16*)(A.ws + WS_KCMP); const u16* vc = (const u16*)(A.ws + WS_VCMP);
#pragma unroll
        for (int i = 0; i < 2; ++i) {
            const int c = tid + 512 * i, n = c >> 3, ch = c & 7;
            const size_t so = ((size_t)(b * 128 + n) * 2 + g) * 64 + ch * 8;
            lds_wr128(L + L3_KC + n * 144 + ch * 16, *(const bf16x8*)(kc + so));
            lds_wr128(L + L3_VC + n * 192 + ch * 16, *(const bf16x8*)(vc + so));
        }
    }
    __syncthreads();
    f32x16 otot[2]; otot[0] = f32x16{}; otot[1] = f32x16{};
    {
        f32x16 sc[4];
        float m = NEGBIG;
#pragma unroll
        for (int kt = 0; kt < 4; ++kt) {
            sc[kt] = f32x16{};
#pragma unroll
            for (int s = 0; s < 4; ++s) sc[kt] = __builtin_amdgcn_mfma_f32_32x32x16_bf16(lds_rd128(L + L3_KC + (kt * 32 + r32) * 144 + (2 * s + h) * 16), qf[s], sc[kt], 0, 0, 0);
#pragma unroll
            for (int rg = 0; rg < 16; ++rg) {
                const int n = kt * 32 + crow(rg, h); const int dist = tq - (16 * n + 31);
                const bool valid = (dist >= 0) && (n < 127);
                const float v = sc[kt][rg] * sc2 - slope2 * (float)dist;
                sc[kt][rg] = valid ? v : NEGBIG;
                m = fmaxf(m, sc[kt][rg]);
            }
            __builtin_amdgcn_sched_barrier(0);
        }
        m = max_halves(m);
        float l = 0.f;
#pragma unroll
        for (int kt = 0; kt < 4; ++kt)
#pragma unroll
            for (int rg = 0; rg < 16; ++rg) { const float p = (sc[kt][rg] > -1e29f) ? __builtin_amdgcn_exp2f(sc[kt][rg] - m) : 0.f; sc[kt][rg] = p; l += p; }
        l = sum_halves(l);
        const float inv = l > 0.f ? 1.f / l : 0.f;
        LAS float* E = (LAS float*)(L + L3_E) + (r * 64 + ql) * 32;
        LAS float* F = (LAS float*)(L + L3_F) + (r * 64 + ql) * 32;
        if (h == 0) F[0] = 0.f;
#pragma unroll
        for (int kt = 0; kt < 4; ++kt)
#pragma unroll
            for (int gq = 0; gq < 4; ++gq) {
                const float p0 = sc[kt][4 * gq] * inv, p1 = sc[kt][4 * gq + 1] * inv, p2 = sc[kt][4 * gq + 2] * inv, p3 = sc[kt][4 * gq + 3] * inv;
                sc[kt][4 * gq] = p0; sc[kt][4 * gq + 1] = p1; sc[kt][4 * gq + 2] = p2; sc[kt][4 * gq + 3] = p3;
                const int j = 8 * kt + 2 * gq + h;
                E[j] = (p0 + p1) + (p2 + p3);
                if (j + 1 < 32) F[j + 1] = p3;
            }
        f32x16 o[2]; o[0] = f32x16{}; o[1] = f32x16{};
#pragma unroll
        for (int ks = 0; ks < 8; ++ks) {
            const int kt = ks >> 1, sb = (ks & 1) * 8;
            u32x4 pw; pw.x = cvtpk(sc[kt][sb], sc[kt][sb + 1]); pw.y = cvtpk(sc[kt][sb + 2], sc[kt][sb + 3]); pw.z = cvtpk(sc[kt][sb + 4], sc[kt][sb + 5]); pw.w = cvtpk(sc[kt][sb + 6], sc[kt][sb + 7]);
            const bf16x8 pf = __builtin_bit_cast(bf16x8, pw);
#pragma unroll
            for (int dt = 0; dt < 2; ++dt) {
                ldsp vp = L + L3_VC + (16 * ks + 4 * h + q4) * 192 + (dt * 32 + 16 * g1 + 4 * p4) * 2;
                o[dt] = __builtin_amdgcn_mfma_f32_32x32x16_bf16(tr_pair(vp, vp + 8 * 192), pf, o[dt], 0, 0, 0);
            }
        }
#pragma unroll
        for (int dt = 0; dt < 2; ++dt)
#pragma unroll
            for (int rg = 0; rg < 16; ++rg) otot[dt][rg] = gate[0] * o[dt][rg];
    }
    __syncthreads();
    {
        const int qq = tid >> 3, sub = tid & 7;
        LAS float* impl = (LAS float*)(L + L3_IMP);
#pragma unroll
        for (int jj = 0; jj < 4; ++jj) {
            const int j = sub * 4 + jj; float s = 0.f;
#pragma unroll
            for (int rr = 0; rr < 4; ++rr) s += ((LAS float*)(L + L3_E))[(rr * 64 + qq) * 32 + j] + ((LAS float*)(L + L3_F))[(rr * 64 + qq) * 32 + j];
            impl[qq * 32 + j] = s;
        }
        __syncthreads();
        const int nfree = 8 - (qt == 0 ? 1 : 2);
        unsigned mk = 0u;
#pragma unroll
        for (int jj = 0; jj < 4; ++jj) {
            const int j = sub * 4 + jj;
            if (j == 0 || j == qt) mk |= 1u << j;
            else if (j < qt) {
                const float mine = impl[qq * 32 + j]; int rank = 0;
                for (int j2 = 1; j2 < qt; ++j2) { const float o2 = impl[qq * 32 + j2]; rank += (o2 > mine || (o2 == mine && j2 < j)) ? 1 : 0; }
                if (rank < nfree) mk |= 1u << j;
            }
        }
        mk |= __shfl_xor(mk, 1); mk |= __shfl_xor(mk, 2); mk |= __shfl_xor(mk, 4);
        if (sub == 0) { selm[qq] = mk; atomicOr((unsigned*)uni, mk); }
        __syncthreads();
        if (tid == 0) {
            const unsigned um = uni[0]; int n = 0;
            for (int j = qt; j >= 0; --j) if ((um >> j) & 1u) jobs[n++] = (1 << 8) | j;
            for (int j = qt; j >= (qt >= 8 ? qt - 8 : 0); --j) jobs[n++] = (2 << 8) | j;
            njobp[0] = n;
        }
        __syncthreads();
    }
    {
        const int njob = __builtin_amdgcn_readfirstlane(njobp[0]);
        float kb[16];
#pragma unroll
        for (int rg = 0; rg < 16; ++rg) kb[rg] = slope2 * (float)crow(rg, h);
        const float c32 = slope2 * 32.f;
        const unsigned mysel = selm[ql];
        const int lrow = tid >> 3, lch = tid & 7;
        float m = NEGBIG, l = 0.f; f32x16 o[2]; o[0] = f32x16{}; o[1] = f32x16{};
        int curkind = 1;
        bf16x8 kreg, vreg;
        {
            const int jb = __builtin_amdgcn_readfirstlane(jobs[0]), kind = jb >> 8, j = jb & 255;
            const u16* src = proj + ((size_t)b * SEQ + 64 * j + lrow) * NPAD + g * 64 + lch * 8;
            kreg = *(const bf16x8*)(src + (kind == 1 ? C_KS : C_KW)); vreg = *(const bf16x8*)(src + (kind == 1 ? C_VS : C_VW));
        }
        lds_wr128(L + L3_BUF + lrow * 144 + lch * 16, kreg);
        lds_wr128(L + L3_BUF + 9216 + lrow * 192 + lch * 16, vreg);
        bf16x8 kreg2 = kreg, vreg2 = vreg;
        if (njob > 1) {
            const int jb = __builtin_amdgcn_readfirstlane(jobs[1]), kind = jb >> 8, j = jb & 255;
            const u16* src = proj + ((size_t)b * SEQ + 64 * j + lrow) * NPAD + g * 64 + lch * 8;
            kreg2 = *(const bf16x8*)(src + (kind == 1 ? C_KS : C_KW)); vreg2 = *(const bf16x8*)(src + (kind == 1 ? C_VS : C_VW));
        }
        __syncthreads();
        auto body = [&](const int i, bf16x8& kld, bf16x8& vld, const bf16x8& kst, const bf16x8& vst) __attribute__((always_inline)) {
            const bool more = i + 1 < njob, more2 = i + 2 < njob;
            const bool wc = i < WCV_PER_THREAD;
            RawF32 wraw; if (wc) wraw = wcv_load(A, unit, i, tid);
            if (more2) {
                const int jb = __builtin_amdgcn_readfirstlane(jobs[i + 2]), kind = jb >> 8, j = jb & 255;
                const u16* src = proj + ((size_t)b * SEQ + 64 * j + lrow) * NPAD + g * 64 + lch * 8;
                kld = *(const bf16x8*)(src + (kind == 1 ? C_KS : C_KW)); vld = *(const bf16x8*)(src + (kind == 1 ? C_VS : C_VW));
            }
            const int jb = __builtin_amdgcn_readfirstlane(jobs[i]), kind = jb >> 8, j = jb & 255;
            if (kind != curkind) {
                const float f = gate[1] * (l > 0.f ? 1.f / l : 0.f);
#pragma unroll
                for (int dt = 0; dt < 2; ++dt)
#pragma unroll
                    for (int rg = 0; rg < 16; ++rg) { otot[dt][rg] += f * o[dt][rg]; o[dt][rg] = 0.f; }
                m = NEGBIG; l = 0.f; curkind = kind;
            }
            ldsp Kb = L + L3_BUF + (i & 1) * L3_BUFSZ, Vb = Kb + 9216;
            const bool wsel = (mysel >> j) & 1u;
            const bool active = (kind == 2) || (__any(wsel) != 0);
            if (active) {
                f32x16 s0 = f32x16{}, s1 = f32x16{};
#pragma unroll
                for (int s = 0; s < 4; ++s) {
                    s0 = __builtin_amdgcn_mfma_f32_32x32x16_bf16(lds_rd128(Kb + r32 * 144 + (2 * s + h) * 16), qf[s], s0, 0, 0, 0);
                    s1 = __builtin_amdgcn_mfma_f32_32x32x16_bf16(lds_rd128(Kb + (32 + r32) * 144 + (2 * s + h) * 16), qf[s], s1, 0, 0, 0);
                }
                const int mtype = (j == qt) ? 1 : ((kind == 2 && j == qt - 8) ? 2 : 0);
                float mx0 = NEGBIG, mx1 = NEGBIG;
                if (mtype == 0) {
#pragma unroll
                    for (int rg = 0; rg < 16; ++rg) {
                        s0[rg] = __builtin_fmaf(s0[rg], sc2, kb[rg]); s1[rg] = __builtin_fmaf(s1[rg], sc2, kb[rg]);
                        mx0 = fmaxf(mx0, s0[rg]); mx1 = fmaxf(mx1, s1[rg]);
                    }
                } else {
#pragma unroll
                    for (int rg = 0; rg < 16; ++rg) {
                        const int c0 = crow(rg, h), c1 = c0 + 32;
                        const bool v0 = (mtype == 1) ? (c0 <= ql) : (c0 > ql), v1 = (mtype == 1) ? (c1 <= ql) : (c1 > ql);
                        s0[rg] = v0 ? __builtin_fmaf(s0[rg], sc2, kb[rg]) : NEGBIG; s1[rg] = v1 ? __builtin_fmaf(s1[rg], sc2, kb[rg]) : NEGBIG;
                        mx0 = fmaxf(mx0, s0[rg]); mx1 = fmaxf(mx1, s1[rg]);
                    }
                }
                const float jbase = slope2 * (float)(64 * j);
                float mb = fmaxf(mx0, mx1 + c32) + jbase;
                mb = max_halves(mb);
                const bool rowok = (kind == 2) || wsel;
                const float mnew = rowok ? fmaxf(m, mb) : m;
                const float alpha = __builtin_amdgcn_exp2f(m - mnew);
                const float e0 = (rowok && mnew > -1e29f) ? (jbase - mnew) : NEGBIG, e1 = e0 + c32;
                float ls = 0.f;
#pragma unroll
                for (int rg = 0; rg < 16; ++rg) {
                    const float p0 = __builtin_amdgcn_exp2f(s0[rg] + e0), p1 = __builtin_amdgcn_exp2f(s1[rg] + e1);
                    s0[rg] = p0; s1[rg] = p1; ls += p0 + p1;
                }
                ls = sum_halves(ls);
                l = l * alpha + ls; m = mnew;
                if (__any(alpha != 1.f)) {
#pragma unroll
                    for (int dt = 0; dt < 2; ++dt)
#pragma unroll
                        for (int rg = 0; rg < 16; ++rg) o[dt][rg] *= alpha;
                }
#pragma unroll
                for (int ks = 0; ks < 4; ++ks) {
                    const int sb = (ks & 1) * 8;
                    u32x4 pw;
                    if (ks < 2) { pw.x = cvtpk(s0[sb], s0[sb + 1]); pw.y = cvtpk(s0[sb + 2], s0[sb + 3]); pw.z = cvtpk(s0[sb + 4], s0[sb + 5]); pw.w = cvtpk(s0[sb + 6], s0[sb + 7]); }
                    else        { pw.x = cvtpk(s1[sb], s1[sb + 1]); pw.y = cvtpk(s1[sb + 2], s1[sb + 3]); pw.z = cvtpk(s1[sb + 4], s1[sb + 5]); pw.w = cvtpk(s1[sb + 6], s1[sb + 7]); }
                    const bf16x8 pf = __builtin_bit_cast(bf16x8, pw);
#pragma unroll
                    for (int dt = 0; dt < 2; ++dt) {
                        ldsp vp = Vb + (16 * ks + 4 * h + q4) * 192 + (dt * 32 + 16 * g1 + 4 * p4) * 2;
                        o[dt] = __builtin_amdgcn_mfma_f32_32x32x16_bf16(tr_pair(vp, vp + 8 * 192), pf, o[dt], 0, 0, 0);
                    }
                }
            }
            if (more) {
                ldsp Kn = L + L3_BUF + ((i + 1) & 1) * L3_BUFSZ;
                lds_wr128(Kn + lrow * 144 + lch * 16, kst);
                lds_wr128(Kn + 9216 + lrow * 192 + lch * 16, vst);
            }
            if (wc) wcv_store(A, unit, i, tid, wraw);
            __syncthreads();
        };
#pragma unroll 1
        for (int i = 0; i < njob; i += 2) {
            body(i, kreg, vreg, kreg2, vreg2);
            if (i + 1 < njob) body(i + 1, kreg2, vreg2, kreg, vreg);
        }
#pragma unroll 1
        for (int i = njob; i < WCV_PER_THREAD; i += 2) {
            const bool two = i + 1 < WCV_PER_THREAD;
            const RawF32 r0 = wcv_load(A, unit, i, tid); RawF32 r1; if (two) r1 = wcv_load(A, unit, i + 1, tid);
            wcv_store(A, unit, i, tid, r0); if (two) wcv_store(A, unit, i + 1, tid, r1);
        }
        {
            const float f = gate[2] * (l > 0.f ? 1.f / l : 0.f);
#pragma unroll
            for (int dt = 0; dt < 2; ++dt)
#pragma unroll
                for (int rg = 0; rg < 16; ++rg) otot[dt][rg] += f * o[dt][rg];
        }
    }
#pragma unroll
    for (int dt = 0; dt < 2; ++dt)
#pragma unroll
        for (int gq = 0; gq < 4; ++gq) {
            *(unsigned*)(mix + trow * DM + 512 + head * 64 + dt * 32 + 8 * gq + 4 * h) = pk4_fp8(otot[dt][4 * gq] * M8SCALE, otot[dt][4 * gq + 1] * M8SCALE, otot[dt][4 * gq + 2] * M8SCALE, otot[dt][4 * gq + 3] * M8SCALE);
        }
    {
        const int cc = tid & 31, tg = tid >> 5;
        const int ch0 = g * 256 + cc * 8;
        const float* cw = A.in[2];
        float w0[8], w1[8], w2[8];
#pragma unroll
        for (int e = 0; e < 8; ++e) { w0[e] = cw[ch0 + e]; w1[e] = cw[512 + ch0 + e]; w2[e] = cw[1024 + ch0 + e]; }
        float cu[6][8];
#pragma unroll
        for (int i = 0; i < 6; ++i) {
            const int t = qt * 64 + tg * 4 + i - 2;
            if (t >= 0) {
                const u16* pr = proj + ((size_t)b * SEQ + t) * NPAD;
                const bf16x8 cv = *(const bf16x8*)(pr + C_C + ch0), uv = *(const bf16x8*)(pr + C_U + ch0);
#pragma unroll
                for (int e = 0; e < 8; ++e) cu[i][e] = bf2f((u16)cv[e]) * bf2f((u16)uv[e]);
            } else {
#pragma unroll
                for (int e = 0; e < 8; ++e) cu[i][e] = 0.f;
            }
        }
#pragma unroll
        for (int i = 0; i < 4; ++i) {
            const int t = qt * 64 + tg * 4 + i;
            const bf16x8 bv = *(const bf16x8*)(proj + ((size_t)b * SEQ + t) * NPAD + C_B + ch0);
            float y[8];
#pragma unroll
            for (int e = 0; e < 8; ++e) y[e] = M8SCALE * bf2f((u16)bv[e]) * (w0[e] * cu[i][e] + w1[e] * cu[i + 1][e] + w2[e] * cu[i + 2][e]);
            u32x2 w; w.x = pk4_fp8(y[0], y[1], y[2], y[3]); w.y = pk4_fp8(y[4], y[5], y[6], y[7]);
            *(u32x2*)(mix + ((size_t)b * SEQ + t) * DM + ch0) = w;
        }
    }
}

constexpr int R8_STAGE = 65536, R8_BYTES = 2 * R8_STAGE, STG8_OFF = R8_BYTES, STG8_WAVE = 2560, TBL8_OFF = STG8_OFF + 8 * STG8_WAVE;
static_assert(TBL8_OFF + 3072 + 3200 + 2048 + 1024 <= LDS_BARW, "P6 LDS map");
__device__ __forceinline__ int swz8(const int r) { return ((r >> 1) & 1) | (((r >> 3) & 1) << 1) | ((((r >> 2) ^ (r >> 3)) & 1) << 2); }
struct Seg8 { unsigned pa[4], pb[4]; const unsigned char* abase; const unsigned char* bbase; unsigned bstep; int nk; };
struct AF8Gather { LAS const int* rtok; const unsigned char* base; __device__ __forceinline__ unsigned off(int row) const { return (unsigned)rtok[row] * (unsigned)DM; } };
struct AF8Dense { const unsigned char* base; unsigned ld; __device__ __forceinline__ unsigned off(int row) const { return (unsigned)row * ld; } };
struct BF8 { const unsigned char* base; unsigned ld; };
template <class AF, class BF>
__device__ __forceinline__ Seg8 make_seg8(const AF& af, const BF& bf, const int nk) {
    const int tid = tid_l(), lane = tid & 63, wid = tid >> 6;
    const int r8 = lane >> 3, c = (lane & 7) ^ swz8(8 * (wid & 1) + r8);
    Seg8 s;
#pragma unroll
    for (int i = 0; i < 4; ++i) s.pa[i] = af.off(8 * (wid + 8 * i) + r8) + c * 16;
#pragma unroll
    for (int i = 0; i < 4; ++i) { const int k = 4 * (wid + 8 * i) + (lane >> 4); const int g = (k & 7) | (((k >> 5) & 1) << 3); s.pb[i] = (unsigned)k * bf.ld + (unsigned)(((lane & 15) ^ g) * 16); }
    s.abase = af.base; s.bbase = bf.base; s.bstep = 128u * bf.ld; s.nk = nk;
    return s;
}
template <int MTN = 4>
__device__ __forceinline__ void seg8_issue(const Seg8& s, const unsigned char* bbase, const int kk, const unsigned dst  , const bool loada = true) {
    const unsigned char* ab = s.abase + (size_t)kk * 128; const unsigned char* bb = bbase + (size_t)kk * s.bstep;
#pragma unroll
    for (int i = 0; i < MTN; ++i) { if (loada) glds16(ab + s.pa[i], (unsigned)__builtin_amdgcn_readfirstlane((int)(dst + i * 8192))); }
#pragma unroll
    for (int i = 0; i < 4; ++i) glds16(bb + s.pb[i], (unsigned)__builtin_amdgcn_readfirstlane((int)(dst + 32768 + i * 8192)));
}
template <int MTN = 4>
__device__ __forceinline__ void dma8_begin(const Seg8& s, ldsp ring, int& slot) {
    const int wid = __builtin_amdgcn_readfirstlane(tid_l() >> 6);
    slot = 0;
    seg8_issue<MTN>(s, s.bbase, 0, (unsigned)(uintptr_t)ring + wid * 1024);
}
typedef int v2i32_t __attribute__((ext_vector_type(2)));
__device__ __forceinline__ i32x8 lds_tr8x4(ldsp p) {
    const v2i32_t a = __builtin_amdgcn_ds_read_tr8_b64_v2i32((LAS v2i32_t*)p), b = __builtin_amdgcn_ds_read_tr8_b64_v2i32((LAS v2i32_t*)(p + 2048)), c = __builtin_amdgcn_ds_read_tr8_b64_v2i32((LAS v2i32_t*)(p + 4096)), d = __builtin_amdgcn_ds_read_tr8_b64_v2i32((LAS v2i32_t*)(p + 6144));
    return (i32x8){a[0], a[1], b[0], b[1], c[0], c[1], d[0], d[1]}; }
__device__ __forceinline__ i32x8 lds_rd256(ldsp p0, ldsp p1) { const i32x4 lo = *(LAS i32x4*)p0, hi = *(LAS i32x4*)p1; return (i32x8){lo[0], lo[1], lo[2], lo[3], hi[0], hi[1], hi[2], hi[3]}; }
template <int MTN = 4>
__device__ __forceinline__ void dma8_run(f32x4 (&acc)[4][2][2][2], const Seg8& cur, const unsigned char* nxt_b, const bool hasnext, int& slot, ldsp ring, const int eops = 0, const bool loada = true, const bool nxt_loada = true) {
    const int tid = tid_l(), lane = tid & 63, wid = __builtin_amdgcn_readfirstlane(tid >> 6);
    const int wm = wid >> 2, wn = wid & 3, l15 = lane & 15, G = lane >> 4;
    const unsigned ra = (unsigned)(uintptr_t)ring + wid * 1024;
    const int ch0 = ((2 * G) ^ swz8(l15)) * 16;
    const int xo0 = (wm * 32 + l15) * 128 + ch0, xo1 = xo0 ^ 16;
    int wo[2][2];
#pragma unroll
    for (int nt = 0; nt < 2; ++nt)
#pragma unroll
        for (int nb = 0; nb < 2; ++nb) wo[nt][nb] = 32768 + (32 * G + (l15 >> 1)) * 256 + (((wn * 4 + nt * 2 + nb) ^ ((l15 >> 1) | ((G & 1) << 3))) * 16) + 8 * (l15 & 1);
    int nk = cur.nk; asm volatile("" : "+s"(nk));
#pragma unroll 1
    for (int kt = 0; kt < nk; ++kt) {
        if (kt == 0) wait_vm(eops); else WAIT_V(0);
        __builtin_amdgcn_s_barrier();
        ldsp cp = ring + slot * R8_STAGE;
        {
            const unsigned d1 = ra + (slot ^ 1) * R8_STAGE;
            if (kt + 1 < nk) seg8_issue<MTN>(cur, cur.bbase, kt + 1, d1, loada);
            else if (hasnext) seg8_issue<MTN>(cur, nxt_b, 0, d1, nxt_loada);
        }
        i32x8 wf[2][2], xa[2];
#pragma unroll
        for (int nt = 0; nt < 2; ++nt)
#pragma unroll
            for (int nb = 0; nb < 2; ++nb) wf[nt][nb] = lds_tr8x4(cp + wo[nt][nb]);
        xa[0] = lds_rd256(cp + xo0, cp + xo1); xa[1] = lds_rd256(cp + xo0 + 2048, cp + xo1 + 2048);
#pragma unroll
        for (int mt = 0; mt < MTN; ++mt) {
#pragma unroll
            for (int tb = 0; tb < 2; ++tb) {
#pragma unroll
                for (int nt = 0; nt < 2; ++nt)
#pragma unroll
                    for (int nb = 0; nb < 2; ++nb) acc[mt][nt][tb][nb] = __builtin_amdgcn_mfma_scale_f32_16x16x128_f8f6f4(wf[nt][nb], xa[tb], acc[mt][nt][tb][nb], 0, 0, 0, 0, 0, 0);
                __builtin_amdgcn_sched_barrier(0);
                if (mt + 1 < MTN) xa[tb] = lds_rd256(cp + xo0 + (mt + 1) * 8192 + tb * 2048, cp + xo1 + (mt + 1) * 8192 + tb * 2048);
                __builtin_amdgcn_sched_barrier(0);
            }
        }
        slot ^= 1;
    }
}

struct BFRouter { const u16* base; size_t kstep; __device__ __forceinline__ unsigned off(int k, int ch) const { return (unsigned)((k * 256 + ch * 8) * 2); } };
#ifndef P4_SKIP
#define P4_SKIP 0
#endif
__device__ __forceinline__ void p4_outproj(const Args& A, ldsp L, const int panel, const int skip) {
    const int tid = tid_l(), lane = tid & 63, wid = tid >> 6, h = lane >> 5, r32 = lane & 31;
    const int wm = wid >> 2, wn = wid & 3;
    const int m0 = panel * 256;
    (void)h; (void)r32; (void)wm; (void)wn; (void)lane;
    const unsigned char* mix8 = A.ws + WS_MIX;
    if (!(skip & 1)) {
        const unsigned char* wo8 = A.ws + WS_WOUT;
        Seg8 cur = make_seg8(AF8Dense{mix8 + (size_t)m0 * DM, (unsigned)DM}, BF8{wo8, 1024u}, DM / 128);
        int slot; dma8_begin<4>(cur, L, slot);
#pragma unroll 1
        for (int nc = 0; nc < 4; ++nc) {
            const bool hasnext = nc < 3;
            f32x4 acc[4][2][2][2];
#pragma unroll
            for (int a_ = 0; a_ < 4; ++a_)
#pragma unroll
                for (int b_ = 0; b_ < 2; ++b_) { acc[a_][b_][0][0] = f32x4{0.f, 0.f, 0.f, 0.f}; acc[a_][b_][0][1] = acc[a_][b_][0][0]; acc[a_][b_][1][0] = acc[a_][b_][0][0]; acc[a_][b_][1][1] = acc[a_][b_][0][0]; }
            dma8_run<4>(acc, cur, wo8 + (nc + 1) * 256, hasnext, slot, L, (nc > 0) ? 16 : 0);
            {
                const int te_ = tid_l(), lane = te_ & 63, wid = te_ >> 6, wm = wid >> 2, wn = wid & 3, l15 = lane & 15, G = lane >> 4;
                ldsp wbuf = L + STG8_OFF + wid * STG8_WAVE;
                u16* ymix = (u16*)(A.ws + WS_YMIX);
#pragma unroll
                for (int mt = 0; mt < 4; ++mt)
#pragma unroll
                    for (int nt = 0; nt < 2; ++nt) {
#pragma unroll
                        for (int tb = 0; tb < 2; ++tb)
#pragma unroll
                            for (int nb = 0; nb < 2; ++nb) { const f32x4 t_ = acc[mt][nt][tb][nb] * (1.f / (W8SCALE * M8SCALE)); u32x2 q; q.x = cvtpk(t_.x, t_.y); q.y = cvtpk(t_.z, t_.w); *(LAS u32x2*)(wbuf + (tb * 16 + l15) * 80 + (nb * 16 + 4 * G) * 2) = q; }
#pragma unroll
                        for (int j = 0; j < 2; ++j) {
                            const bf16x8 o = lds_rd128(wbuf + (j * 16 + (lane >> 2)) * 80 + (lane & 3) * 16);
                            *(bf16x8*)(ymix + (size_t)(m0 + (2 * mt + wm) * 32 + j * 16 + (lane >> 2)) * DM + nc * 256 + wn * 64 + nt * 32 + (lane & 3) * 8) = o;
                        }
                    }
            }
            cur.bbase = wo8 + (nc + 1) * 256;
        }
    }
}
constexpr int RPASS = 1;
__device__ __forceinline__ void p4_ln(const Args& A, ldsp L, const int panel, const int skip) {
    const float* x = A.in[0]; const u16* ymix = (const u16*)(A.ws + WS_YMIX);
    const int tid = tid_l(), lane = tid & 63, wid = tid >> 6, h = lane >> 5, r32 = lane & 31;
    const int wm = wid >> 2, wn = wid & 3;
    const int m0 = panel * 256;
    (void)h; (void)r32; (void)wm; (void)wn; (void)lane;
    float* ybuf = A.out;
    if (!(skip & 2)) {
        const float* gam = A.in[12]; const float* bet = A.in[13];
        u16* x1h = (u16*)(A.ws + WS_X1H); u16* x1l = (u16*)(A.ws + WS_X1L); unsigned char* x1f = A.ws + WS_X1F;
        f32x4 xr[4][4]; u32x2 yr[4][4];
#pragma unroll
        for (int u = 0; u < 4; ++u)
#pragma unroll
            for (int jj = 0; jj < 4; ++jj) { const size_t o_ = ((size_t)m0 + wid * 32 + u) * DM + lane * 4 + 256 * jj; xr[u][jj] = *(const f32x4*)(x + o_); yr[u][jj] = *(const u32x2*)(ymix + o_); }
#pragma unroll 1
        for (int rr = 0; rr < 32; rr += 4) {
            f32x4 v[4][4]; float sm[4];
#pragma unroll
            for (int u = 0; u < 4; ++u) {
                sm[u] = 0.f;
#pragma unroll
                for (int jj = 0; jj < 4; ++jj) {
                    const f32x4 xv = xr[u][jj]; const u32x2 yv = yr[u][jj];
                    v[u][jj].x = ALPHA * xv.x + __uint_as_float(yv.x << 16); v[u][jj].y = ALPHA * xv.y + __uint_as_float(yv.x & 0xffff0000u);
                    v[u][jj].z = ALPHA * xv.z + __uint_as_float(yv.y << 16); v[u][jj].w = ALPHA * xv.w + __uint_as_float(yv.y & 0xffff0000u);
                }
            }
            if (rr + 4 < 32) {
#pragma unroll
                for (int u = 0; u < 4; ++u)
#pragma unroll
                    for (int jj = 0; jj < 4; ++jj) { const size_t o_ = ((size_t)m0 + wid * 32 + rr + 4 + u) * DM + lane * 4 + 256 * jj; xr[u][jj] = *(const f32x4*)(x + o_); yr[u][jj] = *(const u32x2*)(ymix + o_); }
            }
#pragma unroll
            for (int u = 0; u < 4; ++u)
#pragma unroll
                for (int jj = 0; jj < 4; ++jj) sm[u] += (v[u][jj].x + v[u][jj].y) + (v[u][jj].z + v[u][jj].w);
            float mean[4], rstd[4];
#pragma unroll
            for (int u = 0; u < 4; ++u) mean[u] = wave_sum(sm[u]) * (1.f / 1024.f);
#pragma unroll
            for (int u = 0; u < 4; ++u) {
                float q = 0.f;
#pragma unroll
                for (int jj = 0; jj < 4; ++jj) { v[u][jj] = v[u][jj] - mean[u]; q += (v[u][jj].x * v[u][jj].x + v[u][jj].y * v[u][jj].y) + (v[u][jj].z * v[u][jj].z + v[u][jj].w * v[u][jj].w); }
                sm[u] = q;
            }
#pragma unroll
            for (int u = 0; u < 4; ++u) rstd[u] = rsqrtf(wave_sum(sm[u]) * (1.f / 1024.f) + LN_EPS);
#pragma unroll
            for (int jj = 0; jj < 4; ++jj) {
                const int c = lane * 4 + 256 * jj;
                const f32x4 gg = *(const f32x4*)(gam + c), bb = *(const f32x4*)(bet + c);
#pragma unroll
                for (int u = 0; u < 4; ++u) {
                    const size_t row = (size_t)m0 + wid * 32 + rr + u;
                    const f32x4 o = v[u][jj] * rstd[u] * gg + bb;
                    u32x2 wh; wh.x = cvtpk(o.x, o.y); wh.y = cvtpk(o.z, o.w);
                    *(u32x2*)(x1h + row * DM + c) = wh;
                    const float l0 = o.x - __uint_as_float(wh.x << 16), l1 = o.y - __uint_as_float(wh.x & 0xffff0000u), l2 = o.z - __uint_as_float(wh.y << 16), l3 = o.w - __uint_as_float(wh.y & 0xffff0000u);
                    u32x2 wl; wl.x = cvtpk(l0, l1); wl.y = cvtpk(l2, l3);
                    if (RPASS > 1) *(u32x2*)(x1l + row * DM + c) = wl;
                    *(unsigned*)(x1f + row * DM + c) = pk4_fp8(o.x, o.y, o.z, o.w);
                }
            }
        }
    }
}
__device__ __forceinline__ void p4_router(const Args& A, ldsp L, const int panel, const int skip) {
    const int tid = tid_l(), lane = tid & 63, wid = tid >> 6, h = lane >> 5, r32 = lane & 31;
    const int wm = wid >> 2, wn = wid & 3;
    const int m0 = panel * 256;
    (void)h; (void)r32; (void)wm; (void)wn; (void)lane;
    f32x4 lacc[4][2][2][2];
#pragma unroll
    for (int a_ = 0; a_ < 4; ++a_)
#pragma unroll
        for (int b_ = 0; b_ < 2; ++b_) { lacc[a_][b_][0][0] = f32x4{0.f, 0.f, 0.f, 0.f}; lacc[a_][b_][0][1] = lacc[a_][b_][0][0]; lacc[a_][b_][1][0] = lacc[a_][b_][0][0]; lacc[a_][b_][1][1] = lacc[a_][b_][0][0]; }
    {
        const u16* x1h = (const u16*)(A.ws + WS_X1H); const u16* x1l = (const u16*)(A.ws + WS_X1L);
        const u16* rwh = (const u16*)(A.ws + WS_RWH); const u16* rwl = (const u16*)(A.ws + WS_RWL);
        Seg cur = make_seg(AFDense{x1h + (size_t)m0 * DM, (size_t)DM}, BFRouter{rwh, (size_t)32 * 256}, DM / 32);
        int slot; if (!(skip & 4)) dma_begin(cur, L, slot);
#pragma unroll 1
        for (int ps = 0; ps < ((skip & 4) ? 0 : RPASS); ++ps) {
            const bool hasnext = ps + 1 < RPASS;
            const Seg nxt = make_seg(AFDense{(ps == 0 ? x1h : x1l) + (size_t)m0 * DM, (size_t)DM}, BFRouter{ps == 0 ? rwl : rwh, (size_t)32 * 256}, DM / 32);
            dma_run(lacc, cur, nxt, hasnext, slot, L, 0);
            cur = nxt;
        }
    }
    {
        float* lgs = (float*)(A.ws + WS_LGS) + (size_t)blockIdx.x * 256 * 256;
        const int te_ = tid_l(), lane = te_ & 63, wid = te_ >> 6, wm = wid >> 2, wn = wid & 3;
        ldsp wbuf = L + STG_OFF + wid * 4608;
#pragma unroll
        for (int mt = 0; mt < 4; ++mt)
#pragma unroll
            for (int nt = 0; nt < 2; ++nt) {
                f32x4 t[4];
                wave_transpose_f32(lacc[mt][nt], t, wbuf, lane);
#pragma unroll
                for (int j = 0; j < 4; ++j) *(f32x4*)(lgs + (size_t)((2 * mt + wm) * 32 + j * 8 + (lane >> 3)) * 256 + wn * 64 + nt * 32 + (lane & 7) * 4) = t[j];
                asm volatile("" ::: "memory");
            }
    }
}
__device__ __forceinline__ void p4_route(const Args& A, ldsp L, const int panel, const bool dry, const int skip) {
    const int m0 = panel * 256;
    const int tid2 = tid_l(); const int lane2 = tid2 & 63;
    LAS float* lg = (LAS float*)L;
    LAS int* hist = (LAS int*)(L + 131584);
    LAS int* ubase = (LAS int*)(L + 131584 + 1024);
    LAS int* rowe = (LAS int*)(L + 131584 + 2048);
    LAS int* rowr = (LAS int*)(L + 131584 + 2048 + 8192);
    LAS float* roww = (LAS float*)(L + 131584 + 2048 + 16384);
    if (tid2 < 256) hist[tid2] = 0;
    const float* rbias = A.in[15];
#pragma unroll 1
    for (int rd = 0; rd < ((skip & 8) ? 0 : 2); ++rd) {
        {
            const float* lgs = (const float*)(A.ws + WS_LGS) + (size_t)blockIdx.x * 256 * 256 + (size_t)rd * 128 * 256;
#pragma unroll 4
            for (int i = 0; i < 16; ++i) {
                const int idx = i * 512 + tid2, row = idx >> 6, c4 = idx & 63;
                const f32x4 v = *(const f32x4*)(lgs + (size_t)row * 256 + c4 * 4);
                LAS float* d = lg + row * 257 + c4 * 4; d[0] = v.x; d[1] = v.y; d[2] = v.z; d[3] = v.w;
            }
        }
        __syncthreads();
#pragma unroll 1
        for (int pass = 0; pass < 2; ++pass) {
            const int row = pass * 64 + (tid2 >> 3), gi = tid2 & 7;
            const int prow = rd * 128 + row;
            const size_t tok = (size_t)m0 + prow;
            float bv[32];
            float m1 = -INFINITY, m2 = -INFINITY;
#pragma unroll
            for (int e = 0; e < 32; ++e) {
                const float sg = __builtin_amdgcn_rcpf(1.f + __expf(-lg[row * 257 + gi * 32 + e]));
                const float v = sg + rbias[gi * 32 + e];
                bv[e] = v;
                if (v > m1) { m2 = m1; m1 = v; } else if (v > m2) m2 = v;
            }
            const float gs = m1 + m2;
            int rank = 0;
#pragma unroll
            for (int j = 0; j < 8; ++j) { const float o2 = __shfl(gs, (lane2 & ~7) | j); rank += (o2 > gs || (o2 == gs && j < gi)) ? 1 : 0; }
            const bool gsel = rank < 4;
            unsigned taken = 0u;
            int esel[8];
#pragma unroll
            for (int k = 0; k < 8; ++k) {
                float bvv = -INFINITY; int bi = 1 << 20;
                if (gsel) {
#pragma unroll
                    for (int e = 0; e < 32; ++e) { const bool ok = !((taken >> e) & 1u) && bv[e] > bvv; bvv = ok ? bv[e] : bvv; bi = ok ? (gi * 32 + e) : bi; }
                }
#pragma unroll
                for (int o = 1; o < 8; o <<= 1) {
                    const float ov = __shfl_xor(bvv, o); const int oi = __shfl_xor(bi, o);
                    const bool tk = (ov > bvv) || (ov == bvv && oi < bi);
                    bvv = tk ? ov : bvv; bi = tk ? oi : bi;
                }
                if ((bi >> 5) == gi) taken |= 1u << (bi & 31);
                esel[k] = bi;
            }
            if (gi == 0) {
                float sc[8], ssum = 0.f;
#pragma unroll
                for (int k = 0; k < 8; ++k) { sc[k] = 1.f / (1.f + expf(-lg[row * 257 + esel[k]])); ssum += sc[k]; }
#pragma unroll
                for (int k = 0; k < 8; ++k) {
                    roww[prow * 8 + k] = sc[k] / ssum * 2.5f;
                    rowe[prow * 8 + k] = esel[k];
                    rowr[prow * 8 + k] = atomicAdd((int*)&hist[esel[k]], 1);
                }
            }
        }
        __syncthreads();
    }
    const int half = (panel * 256) / TPP;
    if (tid2 < 256) { const int c = hist[tid2]; ubase[tid2] = (c && !dry) ? atomicAdd((int*)(A.ws + WS_CNT) + half * 256 + tid2, c) : 0; }
    __syncthreads();
    {
        u32x2* ssrc = (u32x2*)(A.ws + WS_SSRC);
        if (!dry) for (int i = tid2; i < 2048; i += 512) { const int e = rowe[i]; u32x2 pk; pk.x = (unsigned)(m0 * 8 + i); pk.y = __float_as_uint(roww[i]); ssrc[(size_t)e * ECAP + ubase[e] + rowr[i]] = pk; }
    }
    __syncthreads();
}
__device__ __forceinline__ void p4_unit(const Args& A, ldsp L, const int panel, const bool dry = false) {
    const int skip = dry ? P4_SKIP : 0;
    p4_outproj(A, L, panel, skip);
    VM_WAIT();
    __syncthreads();
    p4_ln(A, L, panel, skip);
    VM_WAIT();
    __syncthreads();
    p4_router(A, L, panel, skip);
    VM_WAIT();
    __syncthreads();
    p4_route(A, L, panel, dry, skip);
}

__device__ __forceinline__ void p5_fill(const Args& A, ldsp L, int bid, int G) {
    const int tid = tid_l();
    LAS int* base = (LAS int*)L;
    LAS int* cl = (LAS int*)(L + 4096);
    const int* cnt = (const int*)(A.ws + WS_CNT);
    cl[tid] = cnt[tid];
    __syncthreads();
    if (tid == 0) { int s = 0; for (int e = 0; e < 2 * NEXP; ++e) { base[e] = s; s += cl[e]; } }
    __syncthreads();
    const int* tok_e = (const int*)(A.ws + WS_TOKE); const float* tok_w = (const float*)(A.ws + WS_TOKW); const int* tok_p = (const int*)(A.ws + WS_TOKP);
    int* ssrc = (int*)(A.ws + WS_SSRC);
    for (size_t i = (size_t)bid * 512 + tid; i < (size_t)T_TOK * 8; i += (size_t)G * 512) {
        const int hf = (int)((i >> 3) / TPP);
        const int d = base[hf * NEXP + tok_e[i]] + tok_p[i];
        u32x2 pk; pk.x = (unsigned)i; pk.y = __float_as_uint(tok_w[i]);
        ((u32x2*)ssrc)[d] = pk;
    }
    __syncthreads();
}

template <int MTN>
__device__ __forceinline__ void p6_tile(const Args& A, ldsp L, const int e, const int lbase, const int nrows, const int tok0, const int mode) {
    const int tid = tid_l();
    LAS int* rtok = (LAS int*)(L + TBL8_OFF);
    LAS int* rsrc = (LAS int*)(L + TBL8_OFF + 1024);
    LAS float* rwt = (LAS float*)(L + TBL8_OFF + 2048);
    const int* ssrc = (const int*)(A.ws + WS_SSRC);
    const unsigned char* x1f = A.ws + WS_X1F;
    unsigned char* hs = A.ws + WS_HS + (size_t)blockIdx.x * 65536;
    if (tid < 256) {
        int tk, sr; float w;
        if (e < NEXP) { const int rr = tid < nrows ? tid : 0; const u32x2 pk = ((const u32x2*)ssrc)[lbase + rr]; const int sv = (int)pk.x; tk = sv >> 3; sr = tid < nrows ? (tk * 16 + (sv & 7)) : -1; w = tid < nrows ? __uint_as_float(pk.y) : 0.f; }
        else { tk = tok0 + lbase + tid; sr = tk * 16 + 8; w = 1.f; }
        rtok[tid] = tk; rsrc[tid] = sr; rwt[tid] = w;
    }
    __syncthreads();
    const unsigned char* wgu = e < NEXP ? A.ws + WS_WGU8 + (size_t)e * 524288 : A.ws + WS_WSH;
    const unsigned char* wd = e < NEXP ? A.ws + WS_WD8 + (size_t)e * 262144 : A.ws + WS_WSH + 524288;
    {
        Seg8 cur = make_seg8(AF8Gather{rtok, x1f}, BF8{wgu, 512u}, DM / 128);
        int slot; dma8_begin<MTN>(cur, L, slot);
#pragma unroll 1
        for (int c = 0; c < 2; ++c) {
            const bool hasnext = c == 0;
            f32x4 acc[4][2][2][2];
#pragma unroll
            for (int a_ = 0; a_ < MTN; ++a_)
#pragma unroll
                for (int b_ = 0; b_ < 2; ++b_) { acc[a_][b_][0][0] = f32x4{0.f, 0.f, 0.f, 0.f}; acc[a_][b_][0][1] = acc[a_][b_][0][0]; acc[a_][b_][1][0] = acc[a_][b_][0][0]; acc[a_][b_][1][1] = acc[a_][b_][0][0]; }
            dma8_run<MTN>(acc, cur, wgu + 256, hasnext, slot, L, (c == 1) ? MTN : 0);
            {
            const int te_ = tid_l(), lane = te_ & 63, wid = te_ >> 6, wm = wid >> 2, wn = wid & 3, l15 = lane & 15, G = lane >> 4;
            ldsp wbuf = L + STG8_OFF + wid * STG8_WAVE;
#pragma unroll
            for (int mt = 0; mt < MTN; ++mt) {
#pragma unroll
                for (int tb = 0; tb < 2; ++tb) {
                    const float wr = rwt[(2 * mt + wm) * 32 + tb * 16 + l15] * (H8SCALE / W8SCALE);
#pragma unroll
                    for (int nb = 0; nb < 2; ++nb) {
                        const f32x4 gv = acc[mt][0][tb][nb] * (1.f / W8SCALE), uv = acc[mt][1][tb][nb];
                        float hv[4];
#pragma unroll
                        for (int e_ = 0; e_ < 4; ++e_) hv[e_] = gv[e_] * __builtin_amdgcn_rcpf(1.f + __expf(-gv[e_])) * (uv[e_] * wr);
                        *(LAS unsigned*)(wbuf + (tb * 16 + l15) * 80 + nb * 16 + 4 * G) = pk4_fp8(hv[0], hv[1], hv[2], hv[3]);
                    }
                }
                const u32x4 o8 = *(LAS u32x4*)(wbuf + (lane >> 1) * 80 + (lane & 1) * 16);
                *(u32x4*)(hs + (size_t)((2 * mt + wm) * 32 + (lane >> 1)) * 256 + c * 128 + wn * 32 + (lane & 1) * 16) = o8;
            }
            }
            cur.bbase = wgu + 256;
        }
    }
    VM_WAIT();
    __syncthreads();
    __builtin_amdgcn_fence(__ATOMIC_ACQUIRE, "agent");
    VM_WAIT();
    __syncthreads();
    {
        Seg8 cur = make_seg8(AF8Dense{hs, 256u}, BF8{wd, 1024u}, 256 / 128);
        int slot; dma8_begin<MTN>(cur, L, slot);
#pragma unroll 1
        for (int nc = 0; nc < 4; ++nc) {
            const bool hasnext = nc < 3;
            f32x4 acc[4][2][2][2];
#pragma unroll
            for (int a_ = 0; a_ < MTN; ++a_)
#pragma unroll
                for (int b_ = 0; b_ < 2; ++b_) { acc[a_][b_][0][0] = f32x4{0.f, 0.f, 0.f, 0.f}; acc[a_][b_][0][1] = acc[a_][b_][0][0]; acc[a_][b_][1][0] = acc[a_][b_][0][0]; acc[a_][b_][1][1] = acc[a_][b_][0][0]; }
            dma8_run<MTN>(acc, cur, wd + (nc + 1) * 256, hasnext, slot, L, (nc > 0) ? 2 * MTN : 0, nc == 0, false);
            {
            const int te_ = tid_l(), lane = te_ & 63, wid = te_ >> 6, wm = wid >> 2, wn = wid & 3, tid = te_;
            ldsp wbuf = L + STG8_OFF + wid * STG8_WAVE;
#pragma unroll
            for (int mt = 0; mt < MTN; ++mt) {
                const int l15 = lane & 15, G = lane >> 4;
#pragma unroll
                for (int nt = 0; nt < 2; ++nt)
#pragma unroll
                    for (int tb = 0; tb < 2; ++tb)
#pragma unroll
                        for (int nb = 0; nb < 2; ++nb) {
                            const f32x4 t_ = acc[mt][nt][tb][nb] * (YSCALE / (W8SCALE * H8SCALE));
                            *(LAS unsigned*)(wbuf + (tb * 16 + l15) * 80 + nt * 32 + nb * 16 + 4 * G) = pk4_fp8(t_.x, t_.y, t_.z, t_.w);
                        }
#pragma unroll
                for (int j = 0; j < 2; ++j) {
                    const int lrow = j * 16 + (lane >> 2);
                    const u32x4 o8 = *(LAS u32x4*)(wbuf + lrow * 80 + (lane & 3) * 16);
                    const int sr = rsrc[(2 * mt + wm) * 32 + lrow];
                    {
                        const int tk = sr >> 4, slot_ = sr & 15;
                        unsigned char* dst = sr < 0 ? (A.ws + WS_TOKE) + ((size_t)blockIdx.x * 512 + tid) * 16
                                 : (slot_ < 7 ? (A.ws + WS_Y + (size_t)(tok0 ? 1 : 0) * YBUF + (size_t)slot_ * YSLOT) + (size_t)(tk - tok0) * 1024
                                              : (unsigned char*)A.out + (size_t)tk * 4096 + (slot_ - 7) * 1024) + nc * 256 + wn * 64 + (lane & 3) * 16;
                        *(u32x4*)dst = o8;
                    }
                }
            }
            }
            cur.bbase = wd + (nc + 1) * 256;
        }
    }
    VM_WAIT();
    __syncthreads();
}
__device__ __forceinline__ void p6_moe(const Args& A, ldsp L, int vcu, int G, const int half, const int mode = 0) {
    const int tid = tid_l();
    LAS int* fstart = (LAS int*)(L + TBL8_OFF + 3072);
    LAS int* sstart = (LAS int*)(L + TBL8_OFF + 3072 + 1040);
    LAS int* ebase = (LAS int*)(L + TBL8_OFF + 3072 + 2080);
    LAS int* cl = (LAS int*)(L + TBL8_OFF + 3072 + 3200);
    const int* cnt = (const int*)(A.ws + WS_CNT);
    __syncthreads();
    cl[tid] = cnt[tid];
    __syncthreads();
    LAS int* tfq = (LAS int*)(L + TBL8_OFF + 3072 + 3200 + 2048);
    if (tid < NEXP) { const int c = cl[half * NEXP + tid], rem = c & 255; tfq[tid] = ((c >> 8) + (rem > 128 ? 1 : 0)) | (((rem > 0 && rem <= 128) ? 1 : 0) << 16); }
    __syncthreads();
    if (tid < NEXP) {
        int a = 0; for (int j = 0; j < tid; ++j) a += tfq[j];
        fstart[tid] = a & 0xffff; sstart[tid] = a >> 16; ebase[tid] = tid * ECAP;
        if (tid == NEXP - 1) { a += tfq[tid]; fstart[NEXP] = a & 0xffff; sstart[NEXP] = a >> 16; }
    }
    __syncthreads();
    const int nfr = fstart[NEXP], nsh = TPP / 256, nsm = sstart[NEXP];
    const int F = nfr + nsh, R = F % G;
    const bool split = (R > 0) && (2 * R + nsm <= G);
    const int nfull = split ? F - R : F, nhalf = split ? 2 * R : 0, ntiles = nfull + nhalf + nsm;
    const int tok0 = half * TPP;
#pragma unroll 1
    for (int tile = vcu; tile < ntiles; tile += G) {
        if (tile < nfull + nhalf) {
            int ft = tile, hsel = -1;
            if (tile >= nfull) { const int u = tile - nfull; ft = nfull + (u >> 1); hsel = u & 1; }
            int e, lbase, nrows;
            if (ft < nfr) {
                int lo = 0, hi = NEXP - 1; while (lo < hi) { const int mid = (lo + hi + 1) >> 1; if (fstart[mid] <= ft) lo = mid; else hi = mid - 1; }
                e = lo; const int r0 = (ft - fstart[e]) * 256; nrows = cl[half * NEXP + e] - r0; if (nrows > 256) nrows = 256; lbase = ebase[e] + r0;
            } else { e = NEXP; lbase = (ft - nfr) * 256; nrows = 256; }
            if (hsel < 0) p6_tile<4>(A, L, e, lbase, nrows, tok0, mode);
            else { const int r0h = hsel * 128; int nr = nrows - r0h; if (nr > 128) nr = 128; if (nr > 0) p6_tile<2>(A, L, e, lbase + r0h, nr, tok0, mode); }
        } else {
            const int q = tile - nfull - nhalf;
            int lo = 0, hi = NEXP - 1; while (lo < hi) { const int mid = (lo + hi + 1) >> 1; if (sstart[mid] <= q) lo = mid; else hi = mid - 1; }
            const int e = lo, c = cl[half * NEXP + e];
            p6_tile<2>(A, L, e, ebase[e] + (c >> 8) * 256, c & 255, tok0, mode);
        }
    }
}

__device__ __forceinline__ void p7_row(const Args& A, const int row, const int tok0, const int lane) {
    const u16* x1h = (const u16*)(A.ws + WS_X1H);
    const float* gam = A.in[22]; const float* bet = A.in[23];
    float v[16];
    {
        const bf16x8 a = *(const bf16x8*)(x1h + (size_t)row * DM + lane * 16), b = *(const bf16x8*)(x1h + (size_t)row * DM + lane * 16 + 8);
#pragma unroll
        for (int e = 0; e < 8; ++e) { v[e] = ALPHA * bf2f((u16)a[e]); v[8 + e] = ALPHA * bf2f((u16)b[e]); }
    }
    float f[16];
#pragma unroll
    for (int e = 0; e < 16; ++e) f[e] = 0.f;
#pragma unroll
    for (int s = 0; s < 9; ++s) {
        const unsigned char* src = s < 7 ? (A.ws + WS_Y + (size_t)(tok0 ? 1 : 0) * YBUF + (size_t)s * YSLOT) + (size_t)(row - tok0) * 1024
                                         : (const unsigned char*)A.out + (size_t)row * 4096 + (s - 7) * 1024;
        const u32x4 w = *(const u32x4*)(src + lane * 16);
#pragma unroll
        for (int i = 0; i < 4; ++i) {
            const f32x2_t lo = __builtin_amdgcn_cvt_pk_f32_fp8((int)w[i], false), hi = __builtin_amdgcn_cvt_pk_f32_fp8((int)w[i], true);
            f[4 * i] += lo.x; f[4 * i + 1] += lo.y; f[4 * i + 2] += hi.x; f[4 * i + 3] += hi.y;
        }
    }
#pragma unroll
    for (int e = 0; e < 16; ++e) v[e] += f[e] * YINV;
    float sm = 0.f;
#pragma unroll
    for (int e = 0; e < 16; ++e) sm += v[e];
    const float mean = wave_sum(sm) * (1.f / 1024.f);
    float q = 0.f;
#pragma unroll
    for (int e = 0; e < 16; ++e) { v[e] -= mean; q += v[e] * v[e]; }
    const float rstd = rsqrtf(wave_sum(q) * (1.f / 1024.f) + LN_EPS);
    float* o = A.out + (size_t)row * DM + lane * 16;
#pragma unroll
    for (int i = 0; i < 4; ++i) {
        const f32x4 gg = *(const f32x4*)(gam + lane * 16 + 4 * i), bb = *(const f32x4*)(bet + lane * 16 + 4 * i);
        f32x4 r; r.x = v[4 * i] * rstd * gg.x + bb.x; r.y = v[4 * i + 1] * rstd * gg.y + bb.y; r.z = v[4 * i + 2] * rstd * gg.z + bb.z; r.w = v[4 * i + 3] * rstd * gg.w + bb.w;
        *(f32x4*)(o + 4 * i) = r;
    }
}
template <int NR>
__device__ __forceinline__ void p7_rows(const Args& A, const int row0, const int rstride, const int tok0, const int lane) {
    const u16* x1h = (const u16*)(A.ws + WS_X1H);
    const float* gam = A.in[22]; const float* bet = A.in[23];
    bf16x8 xa[NR], xb[NR]; u32x4 w[NR][9];
#pragma unroll
    for (int i = 0; i < NR; ++i) {
        const int row = row0 + i * rstride;
        xa[i] = *(const bf16x8*)(x1h + (size_t)row * DM + lane * 16); xb[i] = *(const bf16x8*)(x1h + (size_t)row * DM + lane * 16 + 8);
#pragma unroll
        for (int s = 0; s < 9; ++s) {
            const unsigned char* src = s < 7 ? (A.ws + WS_Y + (size_t)(tok0 ? 1 : 0) * YBUF + (size_t)s * YSLOT) + (size_t)(row - tok0) * 1024
                                             : (const unsigned char*)A.out + (size_t)row * 4096 + (s - 7) * 1024;
            w[i][s] = *(const u32x4*)(src + lane * 16);
        }
    }
    asm volatile("" ::: "memory");
#pragma unroll
    for (int i = 0; i < NR; ++i) {
        const int row = row0 + i * rstride;
        float v[16], f[16];
#pragma unroll
        for (int e = 0; e < 8; ++e) { v[e] = ALPHA * bf2f((u16)xa[i][e]); v[8 + e] = ALPHA * bf2f((u16)xb[i][e]); }
#pragma unroll
        for (int e = 0; e < 16; ++e) f[e] = 0.f;
#pragma unroll
        for (int s = 0; s < 9; ++s)
#pragma unroll
            for (int j = 0; j < 4; ++j) {
                const f32x2_t lo = __builtin_amdgcn_cvt_pk_f32_fp8((int)w[i][s][j], false), hi = __builtin_amdgcn_cvt_pk_f32_fp8((int)w[i][s][j], true);
                f[4 * j] += lo.x; f[4 * j + 1] += lo.y; f[4 * j + 2] += hi.x; f[4 * j + 3] += hi.y;
            }
#pragma unroll
        for (int e = 0; e < 16; ++e) v[e] += f[e] * YINV;
        float sm = 0.f;
#pragma unroll
        for (int e = 0; e < 16; ++e) sm += v[e];
        const float mean = wave_sum(sm) * (1.f / 1024.f);
        float q = 0.f;
#pragma unroll
        for (int e = 0; e < 16; ++e) { v[e] -= mean; q += v[e] * v[e]; }
        const float rstd = rsqrtf(wave_sum(q) * (1.f / 1024.f) + LN_EPS);
        float* o = A.out + (size_t)row * DM + lane * 16;
#pragma unroll
        for (int j = 0; j < 4; ++j) {
            const f32x4 gg = *(const f32x4*)(gam + lane * 16 + 4 * j), bb = *(const f32x4*)(bet + lane * 16 + 4 * j);
            f32x4 r; r.x = v[4 * j] * rstd * gg.x + bb.x; r.y = v[4 * j + 1] * rstd * gg.y + bb.y; r.z = v[4 * j + 2] * rstd * gg.z + bb.z; r.w = v[4 * j + 3] * rstd * gg.w + bb.w;
            *(f32x4*)(o + 4 * j) = r;
        }
    }
}
__device__ __forceinline__ void p7_final(const Args& A, int bid, int G, const int half) {
    const int tid = tid_l(), lane = tid & 63, wid = tid >> 6;
    const int tok0 = half * TPP;
    int row = tok0 + bid * 8 + wid;
    for (; row + G * 8 < tok0 + TPP; row += G * 16) p7_rows<2>(A, row, G * 8, tok0, lane);
    if (row < tok0 + TPP) p7_row(A, row, tok0, lane);
}
__device__ __forceinline__ void p7_queue(const Args& A, ldsp L, const int half) {
    const int tid = tid_l(), lane = tid & 63, wid = tid >> 6;
    LAS int* cw = (LAS int*)(L + TBL_OFF);
    unsigned* head = (unsigned*)(A.ws + WS_P7Q) + half;
    const int tok0 = half * TPP;
    constexpr int NCH = TPP / 32;
    for (;;) {
        __syncthreads();
        if (tid == 0) cw[0] = (int)__hip_atomic_fetch_add(head, 1u, __ATOMIC_RELAXED, __HIP_MEMORY_SCOPE_AGENT);
        __syncthreads();
        const int c = cw[0];
        if (c >= NCH) break;
#pragma unroll 1
        for (int rr = 0; rr < 4; ++rr) p7_row(A, tok0 + c * 32 + wid * 4 + rr, tok0, lane);
    }
}

typedef const __attribute__((address_space(4))) Args* kargp;
__device__ __forceinline__ kargp karg_l(kargp p) { asm volatile("" : "+s"(p)); return p; }
__global__ void __launch_bounds__(512, 2) fwd_kernel(Args A_unused) {
    kargp kp0 = (kargp)__builtin_amdgcn_kernarg_segment_ptr();
#define A (*(const Args*)karg_l(kp0))
    extern __shared__ __attribute__((aligned(16))) unsigned char lds_raw[];
    ldsp L = (ldsp)lds_raw;
    const int tid = tid_l(), G = gridDim.x, bid = blockIdx.x;
    const int vcu = (G % 8 == 0) ? (bid % 8) * (G / 8) + bid / 8 : bid;
    volatile LAS unsigned* barw = (volatile LAS unsigned*)(L + LDS_BARW);
    if (tid < 4) barw[tid] = 0u;
    __syncthreads();
    XcdBarrier bar; bar.bar = (unsigned*)(A.ws + WS_BAR); bar.x = 0; bar.st = barw;
    if (N_LAUNCHES == 1) bar = xcd_barrier_post((unsigned*)(A.ws + WS_BAR), barw);
    const int lo = A.ph_lo, hi = A.ph_hi;
#define IN(k) (lo <= (k) && (k) < hi)
#if defined(PROBE_A)
    unsigned long long tstamp[9]; int nst = 0;
#define STAMP() do { tstamp[nst < 8 ? nst : 8] = __builtin_amdgcn_s_memrealtime(); ++nst; } while (0)
#else
#define STAMP() do {} while (0)
#endif
#define SEAM(k) do { if (IN(k) && IN((k) + 1)) xcd_barrier(bar); STAMP(); } while (0)
    STAMP();

#ifndef DUP_MASK
#define DUP_MASK 0
#endif
#define REP(k) for (int rep_ = 0; rep_ < (((DUP_MASK) >> (k)) & 1) + 1; ++rep_)
    if (IN(0)) REP(0) { p0_prologue(A, L); }
    SEAM(0);
#ifndef P1_EXP
#define P1_EXP 0
#endif
    if (IN(1)) REP(1) { p1_proj(A, L, vcu, G, rep_ == 0 ? 0 : P1_EXP); }
    SEAM(1);
    if (IN(2)) REP(2) { p2_compress(A, L, bid, G); }
    SEAM(2);
    if (IN(3)) REP(3) {
        for (int i = 0; i * G + vcu < 2048; ++i) {
            const int u = i * G + vcu; const int bg = u >> 5, qr = u & 31;
            const int qt = (i & 1) ? 31 - qr : qr;
            int z = 0; asm volatile("" : "+v"(z));
            p3_unit(A, L, bg >> 1, bg & 1, qt, z, u);
            __syncthreads();
        }
    }
    SEAM(3);
#ifndef P4_DUP
#define P4_DUP 0
#endif
    if (IN(4)) { if (P4_DUP) for (int p = vcu; p < T_TOK / 256; p += G) p4_unit(A, L, p, true); for (int p = vcu; p < T_TOK / 256; p += G) p4_unit(A, L, p); }
    if (IN(4) && IN(6)) xcd_barrier(bar);
#ifndef P6_EXP
#define P6_EXP 0
#endif
    if (IN(6)) REP(6) { p6_moe(A, L, vcu, G, 0, rep_ == 0 ? 0 : P6_EXP); }
    SEAM(6);
    if (NPASS == 1) {
        if (IN(7)) { p7_final(A, bid, G, 0); }
    } else {
        if (IN(7)) { p6_moe(A, L, vcu, G, 1); p7_queue(A, L, 0); }
        SEAM(7);
        if (IN(8)) { p7_final(A, bid, G, 1); }
    }
#if defined(PROBE_TILES)
    {
        xcd_barrier(bar);
        const int* cnt = (const int*)(A.ws + WS_CNT);
        float v[2];
        for (int hf = 0; hf < 2; ++hf) { int f = 0, q = 0; for (int e = 0; e < NEXP; ++e) { const int c = cnt[hf * NEXP + e], rem = c & 255; f += (c >> 8) + (rem > 128 ? 1 : 0); q += (rem > 0 && rem <= 128) ? 1 : 0; } v[hf] = (float)(PROBE_TILES == 1 ? f : q); }
        for (size_t i = (size_t)bid * 512 + tid; i < (size_t)T_TOK * DM; i += (size_t)G * 512) A.out[i] = (i == 0) ? 10.f * (v[1] - PROBE_OFF) : (v[0] - PROBE_OFF);
    }
#endif
#if defined(PROBE_A)
    {
        xcd_barrier(bar); STAMP();
        float* pv = (float*)(A.ws + 24576);
        if (bid == 0 && tid == 0) { pv[0] = (float)(tstamp[PROBE_A + 1] - tstamp[PROBE_A]) * 0.01f; pv[1] = (float)(tstamp[PROBE_B + 1] - tstamp[PROBE_B]) * 0.01f * 100.f; }
        xcd_barrier(bar);
        const float v1 = __hip_atomic_load(pv, __ATOMIC_RELAXED, __HIP_MEMORY_SCOPE_AGENT), v2 = __hip_atomic_load(pv + 1, __ATOMIC_RELAXED, __HIP_MEMORY_SCOPE_AGENT);
        for (size_t i = (size_t)bid * 512 + tid; i < (size_t)T_TOK * DM; i += (size_t)G * 512) A.out[i] = (i == 0) ? v2 : v1;
    }
#endif
#undef IN
#undef SEAM
#undef A
}

extern "C" void kernel_launch(void* const* d_in, const int* in_sizes, int n_in, void* d_out, int out_size, void* d_ws, size_t ws_size, hipStream_t stream) {
    static int grid = 0;
    if (grid == 0) {
        if (n_in != 24 || out_size != T_TOK * DM || ws_size < WS_END) { fprintf(stderr, "kernel_launch: unexpected problem (n_in %d out %d ws %zu)\n", n_in, out_size, ws_size); grid = -1; return; }
        int dev = 0, cus = 0;
        if (hipGetDevice(&dev) != hipSuccess || hipDeviceGetAttribute(&cus, hipDeviceAttributeMultiprocessorCount, dev) != hipSuccess) { grid = -1; return; }
        if (hipFuncSetAttribute((const void*)fwd_kernel, hipFuncAttributeMaxDynamicSharedMemorySize, LDS_BYTES) != hipSuccess) { fprintf(stderr, "kernel_launch: hipFuncSetAttribute failed\n"); grid = -1; return; }
        int per_cu = 0;
        if (hipOccupancyMaxActiveBlocksPerMultiprocessor(&per_cu, (const void*)fwd_kernel, 512, LDS_BYTES) != hipSuccess || per_cu < 1) { fprintf(stderr, "kernel_launch: occupancy query says %d\n", per_cu); }
        (void)hipGetLastError();
        grid = cus;
    }
    if (grid < 0) return;
    (void)hipMemsetAsync(d_ws, 0, WS_ZERO_BYTES, stream);
    Args a{};
    for (int i = 0; i < 24; ++i) a.in[i] = (const float*)d_in[i];
    a.out = (float*)d_out; a.ws = (unsigned char*)d_ws;
    if (N_LAUNCHES == 1) {
        a.ph_lo = 0; a.ph_hi = (NPASS == 1) ? 8 : 9;
        hipLaunchKernelGGL(fwd_kernel, dim3(grid), dim3(512), LDS_BYTES, stream, a);
    } else {
        for (int p = 0; p < ((NPASS == 1) ? 8 : 9); ++p) { a.ph_lo = p; a.ph_hi = p + 1; hipLaunchKernelGGL(fwd_kernel, dim3(grid), dim3(512), LDS_BYTES, stream, a); }
    }
}
```
